# Optimizing an MI355X kernel written in HIP

```python
import math
import jax, jax.numpy as jnp
from jax import lax
import numpy as np

D_MODEL = 1024
BATCH = 4
SEQ = 4096
DEPTH = 4

CHUNK = 64
Q_BLOCK = 128
N_MIXERS = 2
N_RET_LAYERS = (DEPTH + 1) // 2
N_DIFF_LAYERS = DEPTH // 2
MIX_WIDTH = D_MODEL
MEM_LEN = 256
MEM_HEADS = 4
MEM_HEAD_DIM = 64
MEM_WIDTH = MEM_HEADS * MEM_HEAD_DIM
MAIN_WIDTH = MIX_WIDTH - MEM_WIDTH
RET_HEADS = 6
RET_V_DIM = MAIN_WIDTH // RET_HEADS
RET_QK_DIM = RET_V_DIM // 2
DIFF_HEADS = 6
DIFF_HEAD_DIM = MAIN_WIDTH // (2 * DIFF_HEADS)
DIFF_V_DIM = 2 * DIFF_HEAD_DIM
IN_WIDTH = 3 * MAIN_WIDTH + MEM_WIDTH
FFN_DIM = -(-8 * D_MODEL // (3 * 256)) * 256
EPS = 1e-6

kernel_name = 'hybrid_retention_diffattn_block'


def rms_norm(x, w):
    x32 = x.astype(jnp.float32)
    y = x32 * lax.rsqrt(jnp.mean(x32 * x32, axis=-1, keepdims=True) + EPS)
    return (y * w.astype(jnp.float32)).astype(x.dtype)


def retention(q, k, v):
    B, S, H, dk = q.shape
    dv = v.shape[-1]
    nc = S // CHUNK
    dt = q.dtype
    log_gamma = jnp.log(1.0 - 2.0 ** (-5.0 - jnp.arange(H, dtype=jnp.float32)))
    k = k * (dk ** -0.5)
    q = q.reshape(B, nc, CHUNK, H, dk)
    k = k.reshape(B, nc, CHUNK, H, dk)
    v = v.reshape(B, nc, CHUNK, H, dv)
    pos = jnp.arange(CHUNK, dtype=jnp.float32)
    d_in = jnp.exp(log_gamma[:, None, None] * jnp.abs(pos[:, None] - pos[None, :])).astype(dt)
    s_in = jnp.einsum('bnihd,bnjhd->bnhij', q, k) * d_in
    o_in = jnp.einsum('bnhij,bnjhe->bnihe', s_in, v)
    k_dec = jnp.exp(log_gamma[:, None] * (CHUNK - 1 - pos)[None, :]).astype(dt)
    kv = jnp.einsum('bnjhd,hj,bnjhe->bnhde', k, k_dec, v)
    chunk_dec = jnp.exp(log_gamma * CHUNK).astype(dt)[:, None, None]

    def step(state, kv_c):
        return state * chunk_dec + kv_c, state

    init = jnp.zeros((B, H, dk, dv), dtype=kv.dtype)
    _, prev = lax.scan(step, init, jnp.moveaxis(kv, 1, 0))
    prev = jnp.moveaxis(prev, 0, 1)
    q_dec = jnp.exp(log_gamma[:, None] * (pos + 1.0)[None, :]).astype(dt)
    o_x = jnp.einsum('bnihd,hi,bnhde->bnihe', q, q_dec, prev)
    return (o_in + o_x).reshape(B, S, H, dv)


def diff_attention(q, k, v, lam):
    B, S, H, _, d = q.shape
    nb = S // Q_BLOCK
    slopes = 2.0 ** (-8.0 * jnp.arange(1, H + 1, dtype=jnp.float32) / H)
    s_pos = jnp.arange(S)
    s_chunk = s_pos // CHUNK
    qb = jnp.moveaxis(q.reshape(B, nb, Q_BLOCK, H, 2, d), 1, 0)
    starts = jnp.arange(nb, dtype=jnp.int32) * Q_BLOCK
    scale = d ** -0.5

    def block(args):
        qblk, t0 = args
        t = t0 + jnp.arange(Q_BLOCK)
        sc = jnp.einsum('bihcd,bjhcd->bhcij', qblk, k).astype(jnp.float32) * scale
        dist = jnp.abs(t[:, None] - s_pos[None, :]).astype(jnp.float32)
        bias = -slopes[:, None, None] * dist[None]
        allowed = s_chunk[None, :] <= (t // CHUNK)[:, None]
        sc = jnp.where(allowed, sc + bias[None, :, None], -jnp.inf)
        p = jax.nn.softmax(sc, axis=-1)
        a = p[:, :, 0] - lam * p[:, :, 1]
        return jnp.einsum('bhij,bjhe->bihe', a.astype(v.dtype), v)

    o = lax.map(block, (qb, starts))
    return jnp.moveaxis(o, 0, 1).reshape(B, S, H, v.shape[-1])


def memory_attention(qc, mk, mv):
    sc = jnp.einsum('bshd,bmhd->bhsm', qc, mk).astype(jnp.float32) * (qc.shape[-1] ** -0.5)
    p = jax.nn.softmax(sc, axis=-1).astype(mv.dtype)
    return jnp.einsum('bhsm,bmhd->bshd', p, mv)


def setup_inputs(seed: int = 0) -> dict:
    key = jax.random.key(seed)
    ks = jax.random.split(key, 24)
    n = jax.random.normal
    f = jnp.float32

    def gain(k, shape):
        return 1.0 + 0.02 * n(k, shape, f)

    return {
        'x': n(ks[0], (BATCH, SEQ, D_MODEL), f),
        'mem': n(ks[1], (BATCH, MEM_LEN, D_MODEL), f),
        'attn_norm_w': gain(ks[2], (DEPTH, D_MODEL)),
        'w_in': n(ks[3], (DEPTH, D_MODEL, IN_WIDTH), f) * D_MODEL ** -0.5,
        'w_out': n(ks[4], (DEPTH, MIX_WIDTH, D_MODEL), f) * MIX_WIDTH ** -0.5,
        'mem_norm_w': gain(ks[5], (D_MODEL,)),
        'w_mem_kv': n(ks[6], (DEPTH, D_MODEL, 2 * MEM_WIDTH), f) * D_MODEL ** -0.5,
        'mem_q_norm_w': gain(ks[7], (DEPTH, MEM_HEAD_DIM)),
        'mem_k_norm_w': gain(ks[8], (DEPTH, MEM_HEAD_DIM)),
        'ret_gn_w': gain(ks[9], (N_RET_LAYERS, RET_HEADS, RET_V_DIM)),
        'diff_q_norm_w': gain(ks[10], (N_DIFF_LAYERS, DIFF_HEAD_DIM)),
        'diff_k_norm_w': gain(ks[11], (N_DIFF_LAYERS, DIFF_HEAD_DIM)),
        'diff_lambda_q1': 0.1 * n(ks[12], (N_DIFF_LAYERS, DIFF_HEAD_DIM), f),
        'diff_lambda_k1': 0.1 * n(ks[13], (N_DIFF_LAYERS, DIFF_HEAD_DIM), f),
        'diff_lambda_q2': 0.1 * n(ks[14], (N_DIFF_LAYERS, DIFF_HEAD_DIM), f),
        'diff_lambda_k2': 0.1 * n(ks[15], (N_DIFF_LAYERS, DIFF_HEAD_DIM), f),
        'diff_subln_w': gain(ks[16], (N_DIFF_LAYERS, DIFF_V_DIM)),
        'ffn_norm_w': gain(ks[17], (DEPTH, D_MODEL)),
        'w_gate_up': n(ks[18], (DEPTH, D_MODEL, 2 * FFN_DIM), f) * D_MODEL ** -0.5,
        'w_down': n(ks[19], (DEPTH, FFN_DIM, D_MODEL), f) * FFN_DIM ** -0.5,
    }


def reference(x, mem, attn_norm_w, w_in, w_out, mem_norm_w, w_mem_kv, mem_q_norm_w,
              mem_k_norm_w, ret_gn_w, diff_q_norm_w, diff_k_norm_w, diff_lambda_q1,
              diff_lambda_k1, diff_lambda_q2, diff_lambda_k2, diff_subln_w, ffn_norm_w,
              w_gate_up, w_down):
    B, S, _ = x.shape
    M = mem.shape[1]
    memn = rms_norm(mem, mem_norm_w)
    for layer in range(DEPTH):
        h = rms_norm(x, attn_norm_w[layer])
        u = h @ w_in[layer]
        j = layer // N_MIXERS
        if layer % N_MIXERS == 0:
            nqk = RET_HEADS * RET_QK_DIM
            q = u[..., :nqk].reshape(B, S, RET_HEADS, RET_QK_DIM)
            k = u[..., nqk:2 * nqk].reshape(B, S, RET_HEADS, RET_QK_DIM)
            v = u[..., 2 * nqk:2 * nqk + MAIN_WIDTH].reshape(B, S, RET_HEADS, RET_V_DIM)
            g = u[..., 2 * nqk + MAIN_WIDTH:3 * MAIN_WIDTH]
            o = rms_norm(retention(q, k, v), ret_gn_w[j])
            o_main = jax.nn.silu(g) * o.reshape(B, S, MAIN_WIDTH)
        else:
            q = u[..., :MAIN_WIDTH].reshape(B, S, DIFF_HEADS, 2, DIFF_HEAD_DIM)
            k = u[..., MAIN_WIDTH:2 * MAIN_WIDTH].reshape(B, S, DIFF_HEADS, 2, DIFF_HEAD_DIM)
            v = u[..., 2 * MAIN_WIDTH:3 * MAIN_WIDTH].reshape(B, S, DIFF_HEADS, DIFF_V_DIM)
            q = rms_norm(q, diff_q_norm_w[j])
            k = rms_norm(k, diff_k_norm_w[j])
            lambda_init = 0.8 - 0.6 * math.exp(-0.3 * layer)
            lq1 = diff_lambda_q1[j].astype(jnp.float32)
            lk1 = diff_lambda_k1[j].astype(jnp.float32)
            lq2 = diff_lambda_q2[j].astype(jnp.float32)
            lk2 = diff_lambda_k2[j].astype(jnp.float32)
            lam = jnp.exp(jnp.sum(lq1 * lk1)) - jnp.exp(jnp.sum(lq2 * lk2)) + lambda_init
            o = rms_norm(diff_attention(q, k, v, lam), diff_subln_w[j]) * (1.0 - lambda_init)
            o_main = o.reshape(B, S, MAIN_WIDTH)
        qc = rms_norm(u[..., 3 * MAIN_WIDTH:].reshape(B, S, MEM_HEADS, MEM_HEAD_DIM), mem_q_norm_w[layer])
        mkv = memn @ w_mem_kv[layer]
        mk = rms_norm(mkv[..., :MEM_WIDTH].reshape(B, M, MEM_HEADS, MEM_HEAD_DIM), mem_k_norm_w[layer])
        mv = mkv[..., MEM_WIDTH:].reshape(B, M, MEM_HEADS, MEM_HEAD_DIM)
        o_mem = memory_attention(qc, mk, mv).reshape(B, S, MEM_WIDTH)
        x = x + jnp.concatenate([o_main, o_mem], axis=-1) @ w_out[layer]
        h = rms_norm(x, ffn_norm_w[layer])
        gu = h @ w_gate_up[layer]
        x = x + (jax.nn.silu(gu[..., :FFN_DIM]) * gu[..., FFN_DIM:]) @ w_down[layer]
    return x
```

```cpp
#include <hip/hip_runtime.h>
#include <hip/hip_cooperative_groups.h>
#include <cstdio>
#include <cstdint>
#define PROBE 0
__device__ __forceinline__ float shx(float v, int o) {
    int l = (int)__builtin_amdgcn_mbcnt_hi(~0u, __builtin_amdgcn_mbcnt_lo(~0u, 0u)); asm volatile("" : "+v"(l));
    return __builtin_bit_cast(float, __builtin_amdgcn_ds_bpermute((l ^ o) << 2, __builtin_bit_cast(int, v)));
}
namespace pg8 {
#define PG8_LAS __attribute__((address_space(3)))
typedef unsigned short bf16_t;
typedef short bf16x8 __attribute__((ext_vector_type(8)));
typedef float f32x4 __attribute__((ext_vector_type(4)));
typedef unsigned u32x4 __attribute__((ext_vector_type(4)));
constexpr int BM = 256, BK = 64, HALF = 128, HTB = HALF * BK * 2  , STAGE_BYTES = 8 * HTB, NXCD = 8, WGM = 8;

__host__ __device__ __forceinline__ int lds_byte(int r, int c) { const int st = (r >> 4) * 2 + (c >> 5), rr = r & 15, cc = c & 31, ob = rr * 64 + cc * 2; return st * 1024 + (ob ^ (((ob >> 9) & 1) << 5)); }
__host__ __device__ __forceinline__ void stage_rc(int b, int& R, int& C) { const int st = b / 1024, sb = b % 1024, swz = sb ^ (((sb >> 9) & 1) << 5); R = (st >> 1) * 16 + swz / 64; C = (st & 1) * 32 + (swz % 64) / 2; }
__host__ __device__ __forceinline__ int perm32(int rho) { const int n = rho >> 4, i = rho & 15; return 8 * (i >> 2) + 4 * n + (i & 3); }

struct Unit { int pm, pn; };
struct Gemm { const bf16_t* A; const bf16_t* Bt; int M, N, K; };

struct StaticOrder {
    int nM, nN, nwg, G, c;
    __host__ __device__ void init(int M, int N, int G_, int c_) { nM = M / BM; nN = N / BM; nwg = nM * nN; G = G_; c = c_; }
    __host__ __device__ bool next(int i, Unit& u) const {
        const long L = (long)i * G + c; if (L >= nwg) return false;
        int wgid = (int)L; { const int q = nwg / NXCD, r = nwg % NXCD, xcd = wgid % NXCD, off = wgid / NXCD; wgid = (xcd < r ? xcd * (q + 1) : r * (q + 1) + (xcd - r) * q) + off; }
        const int nig = WGM * nN, gid = wgid / nig, fm = gid * WGM, gsz = (nM - fm) < WGM ? (nM - fm) : WGM;
        u.pm = fm + ((wgid % nig) % gsz); u.pn = (wgid % nig) / gsz; return true;
    }
    __device__ __forceinline__ void a_ready(const Unit&) const {}
    __device__ __forceinline__ void done(const Unit&) const {}
};

__device__ __forceinline__ unsigned cvt_pk_bf16(float lo, float hi) { unsigned r; asm volatile("v_cvt_pk_bf16_f32 %0, %1, %2" : "=v"(r) : "v"(lo), "v"(hi)); return r; }
typedef float f32x2 __attribute__((ext_vector_type(2)));
typedef PG8_LAS unsigned char PG8_LAS_T;
constexpr float RMS_EPS = 1e-6f;
__device__ __forceinline__ float row_part(const float* ss, int row, int fq) { const f32x4 a = ((const f32x4*)(ss + (size_t)row * 16))[fq]; return (a[0] + a[1]) + (a[2] + a[3]); }
__device__ __forceinline__ float row_finish(float t) { t += shx(t, 16); t += shx(t, 32); return __builtin_amdgcn_rsqf(t * (1.0f / 1024.0f) + RMS_EPS); }
__device__ __forceinline__ float silu_f(float v) { return v * __builtin_amdgcn_rcpf(1.0f + __builtin_amdgcn_exp2f(v * -1.4426950408889634f)); }
__device__ __forceinline__ f32x4 silu4(f32x4 v) { return (f32x4){silu_f(v[0]), silu_f(v[1]), silu_f(v[2]), silu_f(v[3])}; }
__device__ __forceinline__ float sq4(f32x4 v) { return (v[0] * v[0] + v[1] * v[1]) + (v[2] * v[2] + v[3] * v[3]); }
__device__ __forceinline__ u32x4 pack8(f32x4 a, f32x4 b) { u32x4 w; w.x = cvt_pk_bf16(a[0], a[1]); w.y = cvt_pk_bf16(a[2], a[3]); w.z = cvt_pk_bf16(b[0], b[1]); w.w = cvt_pk_bf16(b[2], b[3]); return w; }

struct EpiU {
    static constexpr bool PERM = true, AFTER_DRAIN = false;
    bf16_t* U; const float* ss; int diff; const float *qw, *kw, *mqw; float qscale;
    __device__ __forceinline__ void operator()(const f32x4 (&acc)[2][2][4][2], const Unit& u, int wr, int wc, int fr, int fq) const {
        const int g = u.pn * 4 + wc;
        int mode = 0; const float* w = mqw; float sc = 1.f, nsc = 1.f;
        if (g >= 36) { mode = 2; w = mqw; nsc = qscale; }
        else if (diff) { if (g < 12) { mode = 2; w = qw; nsc = qscale; } else if (g < 24) { mode = 2; w = kw; } }
        else { if (g >= 6 && g < 12) sc = 0.125f; else if (g >= 24) mode = 1; }
        f32x4 wv[2][2];
#pragma unroll
        for (int bj = 0; bj < 2; ++bj)
#pragma unroll
            for (int n = 0; n < 2; ++n) wv[bj][n] = *(const f32x4*)(w + 32 * bj + 8 * fq + 4 * n) * nsc;
        const int lcol = u.pn * 256 + 64 * wc + 8 * fq;
        float rs[2][4];
#pragma unroll
        for (int ai = 0; ai < 2; ++ai)
#pragma unroll
            for (int m = 0; m < 4; ++m) rs[ai][m] = row_part(ss, u.pm * BM + ai * HALF + wr * 64 + m * 16 + fr, fq);
#pragma unroll
        for (int ai = 0; ai < 2; ++ai)
#pragma unroll
            for (int m = 0; m < 4; ++m) rs[ai][m] = row_finish(rs[ai][m]);
#pragma unroll
        for (int ai = 0; ai < 2; ++ai)
#pragma unroll
            for (int m = 0; m < 4; ++m) {
                const int row = u.pm * BM + ai * HALF + wr * 64 + m * 16 + fr;
                const float rstd = rs[ai][m];
                f32x4 v[2][2];
#pragma unroll
                for (int bj = 0; bj < 2; ++bj)
#pragma unroll
                    for (int n = 0; n < 2; ++n) v[bj][n] = acc[ai][bj][m][n] * rstd;
                if (mode == 2) {
                    float q = (sq4(v[0][0]) + sq4(v[0][1])) + (sq4(v[1][0]) + sq4(v[1][1]));
                    q += shx(q, 16); q += shx(q, 32);
                    const float r2 = __builtin_amdgcn_rsqf(q * (1.0f / 64.0f) + RMS_EPS);
#pragma unroll
                    for (int bj = 0; bj < 2; ++bj)
#pragma unroll
                        for (int n = 0; n < 2; ++n) v[bj][n] = v[bj][n] * r2 * wv[bj][n];
                } else if (mode == 1) {
#pragma unroll
                    for (int bj = 0; bj < 2; ++bj)
#pragma unroll
                        for (int n = 0; n < 2; ++n) v[bj][n] = silu4(v[bj][n]);
                } else {
#pragma unroll
                    for (int bj = 0; bj < 2; ++bj)
#pragma unroll
                        for (int n = 0; n < 2; ++n) v[bj][n] = v[bj][n] * sc;
                }
                bf16_t* rowp = U + (size_t)row * 2560 + lcol;
#pragma unroll
                for (int bj = 0; bj < 2; ++bj) *(u32x4*)(rowp + 32 * bj) = pack8(v[bj][0], v[bj][1]);
            }
    }
};
struct EpiMKV {
    static constexpr bool PERM = true, AFTER_DRAIN = false;
    bf16_t* MKV; const float* mkw;
    __device__ __forceinline__ void operator()(const f32x4 (&acc)[2][2][4][2], const Unit& u, int wr, int wc, int fr, int fq) const {
        const int layer = u.pn >> 1, isv = u.pn & 1;
        const float* w = mkw + layer * 64;
        f32x4 wv[2][2];
#pragma unroll
        for (int bj = 0; bj < 2; ++bj)
#pragma unroll
            for (int n = 0; n < 2; ++n) wv[bj][n] = *(const f32x4*)(w + 32 * bj + 8 * fq + 4 * n);
        const int lcol = isv * 256 + 64 * wc + 8 * fq;
#pragma unroll
        for (int ai = 0; ai < 2; ++ai)
#pragma unroll
            for (int m = 0; m < 4; ++m) {
                const int row = u.pm * BM + ai * HALF + wr * 64 + m * 16 + fr;
                f32x4 v[2][2];
#pragma unroll
                for (int bj = 0; bj < 2; ++bj)
#pragma unroll
                    for (int n = 0; n < 2; ++n) v[bj][n] = acc[ai][bj][m][n];
                if (!isv) {
                    float q = (sq4(v[0][0]) + sq4(v[0][1])) + (sq4(v[1][0]) + sq4(v[1][1]));
                    q += shx(q, 16); q += shx(q, 32);
                    const float r2 = __builtin_amdgcn_rsqf(q * (1.0f / 64.0f) + RMS_EPS);
#pragma unroll
                    for (int bj = 0; bj < 2; ++bj)
#pragma unroll
                        for (int n = 0; n < 2; ++n) v[bj][n] = v[bj][n] * r2 * wv[bj][n];
                }
                bf16_t* rowp = MKV + ((size_t)layer * 1024 + row) * 512 + lcol;
#pragma unroll
                for (int bj = 0; bj < 2; ++bj) *(u32x4*)(rowp + 32 * bj) = pack8(v[bj][0], v[bj][1]);
            }
    }
};
struct EpiRes {
    static constexpr bool PERM = true, AFTER_DRAIN = false;
    float* out; bf16_t* xb; float* ss; int last;
    __device__ __forceinline__ void operator()(const f32x4 (&acc)[2][2][4][2], const Unit& u, int wr, int wc, int fr, int fq) const {
        const int col0 = u.pn * 256 + 32 * wc + 8 * fq;
#pragma unroll
        for (int ai = 0; ai < 2; ++ai) {
            u32x4 bs[4][2];
#pragma unroll
            for (int m = 0; m < 4; ++m)
#pragma unroll
                for (int bj = 0; bj < 2; ++bj) bs[m][bj] = *(const u32x4*)(xb + (size_t)(u.pm * BM + ai * HALF + wr * 64 + m * 16 + fr) * 1024 + col0 + 128 * bj);
#pragma unroll
            for (int m = 0; m < 4; ++m) {
                const int row = u.pm * BM + ai * HALF + wr * 64 + m * 16 + fr;
                float q = 0.f;
#pragma unroll
                for (int bj = 0; bj < 2; ++bj) {
                    const size_t off = (size_t)row * 1024 + col0 + 128 * bj; const u32x4 w = bs[m][bj];
                    const f32x4 b0 = (f32x4){__builtin_bit_cast(float, w.x << 16), __builtin_bit_cast(float, w.x & 0xffff0000u), __builtin_bit_cast(float, w.y << 16), __builtin_bit_cast(float, w.y & 0xffff0000u)};
                    const f32x4 b1 = (f32x4){__builtin_bit_cast(float, w.z << 16), __builtin_bit_cast(float, w.z & 0xffff0000u), __builtin_bit_cast(float, w.w << 16), __builtin_bit_cast(float, w.w & 0xffff0000u)};
                    const f32x4 v0 = acc[ai][bj][m][0] + b0, v1 = acc[ai][bj][m][1] + b1;
                    if (last) { __builtin_nontemporal_store(v0, (f32x4*)(out + off)); __builtin_nontemporal_store(v1, (f32x4*)(out + off + 4)); }
                    else { q += sq4(v0) + sq4(v1); *(u32x4*)(xb + off) = pack8(v0, v1); }
                }
                if (!last) { q += shx(q, 16); q += shx(q, 32); if (fq == 0) ss[(size_t)row * 16 + u.pn * 4 + wc] = q; }
            }
        }
    }
};
struct EpiSwi {
    static constexpr bool PERM = true, AFTER_DRAIN = false;
    bf16_t* ACT; const float* ss;
    __device__ __forceinline__ void operator()(const f32x4 (&acc)[2][2][4][2], const Unit& u, int wr, int wc, int fr, int fq) const {
        const int col0 = u.pn * 128 + 32 * wc + 8 * fq;
        float rs[2][4];
#pragma unroll
        for (int ai = 0; ai < 2; ++ai)
#pragma unroll
            for (int m = 0; m < 4; ++m) rs[ai][m] = row_part(ss, u.pm * BM + ai * HALF + wr * 64 + m * 16 + fr, fq);
#pragma unroll
        for (int ai = 0; ai < 2; ++ai)
#pragma unroll
            for (int m = 0; m < 4; ++m) rs[ai][m] = row_finish(rs[ai][m]);
#pragma unroll
        for (int ai = 0; ai < 2; ++ai)
#pragma unroll
            for (int m = 0; m < 4; ++m) {
                const int row = u.pm * BM + ai * HALF + wr * 64 + m * 16 + fr;
                const float rstd = rs[ai][m];
                const f32x4 a0 = silu4(acc[ai][0][m][0] * rstd) * (acc[ai][1][m][0] * rstd);
                const f32x4 a1 = silu4(acc[ai][0][m][1] * rstd) * (acc[ai][1][m][1] * rstd);
                *(u32x4*)(ACT + (size_t)row * 2816 + col0) = pack8(a0, a1);
            }
    }
};
struct TailOrder {
    int nM, nN, first, c;
    __device__ bool next(int i, Unit& u) const { if (i > 0) return false; const int t = c - first; if (t < 0 || t >= nM * nN) return false; u.pm = t % nM; u.pn = t / nM; return true; }
    __device__ __forceinline__ void a_ready(const Unit&) const {}
    __device__ __forceinline__ void done(const Unit&) const {}
};
template <class Epi, class Sched, bool ALIGN_EPI = false, bool SP2 = false>
__device__ __forceinline__ void gemm_phase(PG8_LAS unsigned char* lds, const Gemm g, const Sched& S, const Epi& E, int tid_in) {
    int tid_ = tid_in; asm volatile("" : "+v"(tid_));
    const int tid = tid_, wid = __builtin_amdgcn_readfirstlane(tid >> 6), lane = tid & 63, wr = wid >> 2, wc = wid & 3, fr = lane & 15, fq = lane >> 4;
    const int K = g.K, nt = K / BK;
    unsigned voffA[2], voffB[2];
#pragma unroll
    for (int i = 0; i < 2; ++i) { int R, C; stage_rc(tid * 16 + i * 8192, R, C); const int Rb = Epi::PERM ? ((R & ~31) + perm32(R & 31)) : R;
        voffA[i] = (unsigned)(R * K + C) * 2u; voffB[i] = (unsigned)(Rb * K + C) * 2u; }
    const size_t kstep = (size_t)(BK * 2);
    const size_t hstep = (size_t)HALF * K * 2;
    const size_t tstep = 2 * hstep;
    const unsigned ldsw = (unsigned)wid * 1024u;
    const int aoff = lds_byte(wr * 64 + fr, fq * 8), boff = lds_byte(wc * 32 + fr, fq * 8);
#define PG8_SA(b, h) (((b) * 2 + (h)) * HTB)
#define PG8_SB(b, h) ((4 + (b) * 2 + (h)) * HTB)
#define PG8_STAGE(bufoff, gbase, voff) do { _Pragma("unroll") for (int _i = 0; _i < 2; ++_i) \
        __builtin_amdgcn_global_load_lds((const unsigned*)((const char*)(gbase) + (voff)[_i]), (PG8_LAS unsigned*)(lds + (bufoff) + ldsw + _i * 8192), 16, 0, 0); } while (0)
#define PG8_LDA(dst, b, h) do { _Pragma("unroll") for (int m = 0; m < 4; ++m) _Pragma("unroll") for (int k = 0; k < 2; ++k) dst[m][k] = *(const PG8_LAS bf16x8*)(lds + PG8_SA(b, h) + aoff + m * 2048 + k * 1024); } while (0)
#define PG8_LDB(dst, b, h) do { _Pragma("unroll") for (int n = 0; n < 2; ++n) _Pragma("unroll") for (int k = 0; k < 2; ++k) dst[n][k] = *(const PG8_LAS bf16x8*)(lds + PG8_SB(b, h) + boff + n * 2048 + k * 1024); } while (0)
#define PG8_MMA(ai, bj, At, Bt) do { __builtin_amdgcn_s_setprio(1); _Pragma("unroll") for (int m = 0; m < 4; ++m) _Pragma("unroll") for (int n = 0; n < 2; ++n) _Pragma("unroll") for (int k = 0; k < 2; ++k) \
        acc[ai][bj][m][n] = __builtin_amdgcn_mfma_f32_16x16x32_bf16(Bt[n][k], At[m][k], acc[ai][bj][m][n], 0, 0, 0); __builtin_amdgcn_s_setprio(0); } while (0)
#define PG8_WAIT_V(n) asm volatile("s_waitcnt vmcnt(" #n ")" ::: "memory")
#define PG8_WAIT_L(n) asm volatile("s_waitcnt lgkmcnt(" #n ")" ::: "memory")
#define PG8_BAR __builtin_amdgcn_s_barrier()
#define PG8_SCHED __builtin_amdgcn_sched_barrier(0)
    Unit cur, nxt; int ui = 0;
    if (!S.next(0, cur)) return;
    f32x4 acc[2][2][4][2];
#pragma unroll
    for (int a = 0; a < 2; ++a)
#pragma unroll
        for (int b = 0; b < 2; ++b)
#pragma unroll
            for (int m = 0; m < 4; ++m)
#pragma unroll
                for (int n = 0; n < 2; ++n) acc[a][b][m][n] = (f32x4){0.f, 0.f, 0.f, 0.f};
    bf16x8 At[4][2], B0[2][2], B1[2][2];
    const char* cA = (const char*)g.A + (size_t)cur.pm * tstep; const char* cB = (const char*)g.Bt + (size_t)cur.pn * tstep;
    S.a_ready(cur);
    if constexpr (SP2) {
        PG8_STAGE(PG8_SB(0, 0), cB, voffB); PG8_STAGE(PG8_SB(0, 1), cB + hstep, voffB); PG8_STAGE(PG8_SA(0, 0), cA, voffA); PG8_STAGE(PG8_SA(0, 1), cA + hstep, voffA);
        if (wr == 1) PG8_BAR;
        PG8_WAIT_V(2); PG8_BAR;
        PG8_STAGE(PG8_SB(1, 0), cB + kstep, voffB); PG8_STAGE(PG8_SA(1, 0), cA + kstep, voffA); PG8_STAGE(PG8_SB(1, 1), cB + hstep + kstep, voffB);
        PG8_WAIT_V(6); PG8_BAR;
    } else {
        PG8_STAGE(PG8_SB(0, 0), cB, voffB); PG8_STAGE(PG8_SA(0, 0), cA, voffA); PG8_STAGE(PG8_SB(0, 1), cB + hstep, voffB); PG8_STAGE(PG8_SA(0, 1), cA + hstep, voffA);
        if (wr == 1) PG8_BAR;
        PG8_WAIT_V(4); PG8_BAR;
        PG8_STAGE(PG8_SB(1, 0), cB + kstep, voffB); PG8_STAGE(PG8_SA(1, 0), cA + kstep, voffA); PG8_STAGE(PG8_SB(1, 1), cB + hstep + kstep, voffB);
        PG8_WAIT_V(6); PG8_BAR;
    }
    for (;;) {
        const bool has_next = S.next(ui + 1, nxt);
        const char* nA = has_next ? (const char*)g.A + (size_t)nxt.pm * tstep : cA; const char* nB = has_next ? (const char*)g.Bt + (size_t)nxt.pn * tstep : cB;
        for (int t = 0; t < nt; t += 2) {
            const bool last = (t == nt - 2);
            const char* a1 = cA + (size_t)(t + 1) * kstep;
            const char* a2 = last ? nA : cA + (size_t)(t + 2) * kstep; const char* b2 = last ? nB : cB + (size_t)(t + 2) * kstep;
            const char* a3 = a2 + kstep; const char* b3 = b2 + kstep;
            if (last && has_next) S.a_ready(nxt);
            if constexpr (SP2) {
            PG8_LDB(B0, 0, 0); PG8_LDB(B1, 0, 1); PG8_SCHED; PG8_LDA(At, 0, 0); PG8_STAGE(PG8_SA(1, 1), a1 + hstep, voffA);
            PG8_WAIT_V(8); PG8_WAIT_L(0); PG8_BAR; PG8_MMA(0, 0, At, B0); PG8_MMA(0, 1, At, B1); PG8_BAR; PG8_SCHED;
            PG8_LDA(At, 0, 1); PG8_STAGE(PG8_SB(0, 0), b2, voffB); PG8_STAGE(PG8_SB(0, 1), b2 + hstep, voffB); PG8_STAGE(PG8_SA(0, 0), a2, voffA);
            PG8_WAIT_V(8); PG8_WAIT_L(0); PG8_BAR; PG8_MMA(1, 0, At, B0); PG8_MMA(1, 1, At, B1); PG8_BAR; PG8_SCHED;
            PG8_LDB(B0, 1, 0); PG8_LDB(B1, 1, 1); PG8_SCHED; PG8_LDA(At, 1, 0); PG8_STAGE(PG8_SA(0, 1), a2 + hstep, voffA);
            PG8_WAIT_V(8); PG8_WAIT_L(0); PG8_BAR; PG8_MMA(0, 0, At, B0); PG8_MMA(0, 1, At, B1); PG8_BAR; PG8_SCHED;
            PG8_LDA(At, 1, 1); PG8_STAGE(PG8_SB(1, 0), b3, voffB); PG8_STAGE(PG8_SB(1, 1), b3 + hstep, voffB); PG8_STAGE(PG8_SA(1, 0), a3, voffA);
            PG8_WAIT_V(8); PG8_WAIT_L(0); PG8_BAR; PG8_MMA(1, 0, At, B0); PG8_MMA(1, 1, At, B1); PG8_BAR; PG8_SCHED;
            } else {
            PG8_LDB(B0, 0, 0); PG8_SCHED; PG8_LDA(At, 0, 0); PG8_STAGE(PG8_SA(1, 1), a1 + hstep, voffA);
            PG8_WAIT_L(8); PG8_BAR; PG8_WAIT_L(0); PG8_MMA(0, 0, At, B0); PG8_BAR; PG8_SCHED;
            PG8_LDB(B1, 0, 1); PG8_STAGE(PG8_SB(0, 0), b2, voffB);
            PG8_BAR; PG8_WAIT_L(0); PG8_MMA(0, 1, At, B1); PG8_BAR;
            PG8_LDA(At, 0, 1); PG8_STAGE(PG8_SA(0, 0), a2, voffA);
            PG8_BAR; PG8_WAIT_L(0); PG8_MMA(1, 0, At, B0); PG8_BAR; PG8_SCHED;
            PG8_STAGE(PG8_SB(0, 1), b2 + hstep, voffB);
            PG8_WAIT_V(6); PG8_BAR; PG8_MMA(1, 1, At, B1); PG8_BAR;
            PG8_LDB(B0, 1, 0); PG8_SCHED; PG8_LDA(At, 1, 0); PG8_STAGE(PG8_SA(0, 1), a2 + hstep, voffA);
            PG8_WAIT_L(8); PG8_BAR; PG8_WAIT_L(0); PG8_MMA(0, 0, At, B0); PG8_BAR; PG8_SCHED;
            PG8_LDB(B1, 1, 1); PG8_STAGE(PG8_SB(1, 0), b3, voffB);
            PG8_BAR; PG8_WAIT_L(0); PG8_MMA(0, 1, At, B1); PG8_BAR;
            PG8_LDA(At, 1, 1); PG8_STAGE(PG8_SA(1, 0), a3, voffA);
            PG8_BAR; PG8_WAIT_L(0); PG8_MMA(1, 0, At, B0); PG8_BAR; PG8_SCHED;
            PG8_STAGE(PG8_SB(1, 1), b3 + hstep, voffB);
            PG8_WAIT_V(6); PG8_BAR; PG8_MMA(1, 1, At, B1); PG8_BAR;
            }
        }
        if constexpr (ALIGN_EPI) { if (wr == 0) PG8_BAR; }
        if constexpr (!Epi::AFTER_DRAIN) { E(acc, cur, wr, wc, fr, fq); S.done(cur); }
        if (!has_next) break;
#pragma unroll
        for (int a = 0; a < 2; ++a)
#pragma unroll
            for (int b = 0; b < 2; ++b)
#pragma unroll
                for (int m = 0; m < 4; ++m)
#pragma unroll
                    for (int n = 0; n < 2; ++n) acc[a][b][m][n] = (f32x4){0.f, 0.f, 0.f, 0.f};
        cur = nxt; cA = nA; cB = nB; ++ui;
        if constexpr (ALIGN_EPI) { if (wr == 1) PG8_BAR; }
    }
    PG8_WAIT_V(0);
    if constexpr (!ALIGN_EPI) { if (wr == 0) PG8_BAR; }
    PG8_BAR;
    if constexpr (Epi::AFTER_DRAIN) { E.fused(acc, cur, wr, wc, fr, fq, lds, wid, lane); S.done(cur); }
#undef PG8_SA
#undef PG8_SB
#undef PG8_STAGE
#undef PG8_LDA
#undef PG8_LDB
#undef PG8_MMA
#undef PG8_WAIT_V
#undef PG8_WAIT_L
#undef PG8_BAR
#undef PG8_SCHED
}
}

namespace cg = cooperative_groups;
#define LAS __attribute__((address_space(3)))
typedef unsigned short bf16;
typedef unsigned v4u __attribute__((ext_vector_type(4)));
typedef unsigned v2u __attribute__((ext_vector_type(2)));
typedef float f32x4 __attribute__((ext_vector_type(4)));

constexpr int NWAVES = 8, NTHR = 512;
constexpr int BATCH = 4, SEQ = 4096, D = 1024, M = BATCH * SEQ, DEPTH = 4;
constexpr int INW = 2560, FFN = 2816, GU = 2 * FFN, MEMR = BATCH * 256, MAINW = 768;
constexpr float EPS = 1e-6f;
constexpr size_t MiB = 1u << 20;
constexpr size_t WS_CTL = 0;
constexpr size_t WS_WIN = 1 * MiB;
constexpr size_t WS_WOUT = 21 * MiB;
constexpr size_t WS_WGU = 29 * MiB;
constexpr size_t WS_WDN = 73 * MiB;
constexpr size_t WS_WMKV = 95 * MiB;
constexpr size_t WS_MEMN = 99 * MiB;
constexpr size_t WS_MKV = 101 * MiB;
constexpr size_t WS_XB = 105 * MiB;
constexpr size_t WS_SS = 137 * MiB;
constexpr size_t WS_U = 138 * MiB;
constexpr size_t WS_O = 218 * MiB;
constexpr size_t WS_ACT = WS_U;
constexpr size_t WS_KV = 250 * MiB;
constexpr size_t WS_END = 298 * MiB;
constexpr int LDS_BYTES = 147456;

__device__ __forceinline__ unsigned f2bf(float f) { unsigned u = __builtin_bit_cast(unsigned, f); return (u + 0x7fffu + ((u >> 16) & 1u)) >> 16; }
__device__ __forceinline__ unsigned pk2(float lo, float hi) { return f2bf(lo) | (f2bf(hi) << 16); }
__device__ __forceinline__ float bflo(unsigned w) { return __builtin_bit_cast(float, w << 16); }
__device__ __forceinline__ float bfhi(unsigned w) { return __builtin_bit_cast(float, w & 0xffff0000u); }
__device__ __forceinline__ float wave_sum(float v) {
#pragma unroll
    for (int o = 1; o < 64; o <<= 1) v += shx(v, o);
    return v;
}

struct Args {
    const float* in[20]; float* out; unsigned char* ws;
};

__device__ __forceinline__ int map_row(int n, int mode) {
    if (mode == 1) return (n & ~255) + 128 * ((n >> 5) & 1) + 32 * ((n >> 6) & 3) + (n & 31);
    if (mode == 2) { if (n < FFN) return 256 * (n / 128) + (n % 128); const int j = n - FFN; return 256 * (j / 128) + 128 + (j % 128); }
    return n;
}
__device__ __forceinline__ void transpose_item(const float* __restrict__ W, int K, int N, bf16* __restrict__ WT, const float* __restrict__ ksc, int mode, int row_off, int item, int lane) {
    const int nblk = N / 64, kb = item / nblk, nb = item % nblk, k0 = 64 * kb, n = 64 * nb + lane;
    const float* src = W + (size_t)k0 * N + n;
    float v[64];
#pragma unroll
    for (int i = 0; i < 64; ++i) v[i] = __builtin_nontemporal_load(src + (size_t)i * N);
    if (ksc) {
#pragma unroll
        for (int i = 0; i < 64; ++i) v[i] *= ksc[k0 + i];
    }
    bf16* dst = WT + (size_t)(row_off + map_row(n, mode)) * K + k0;
#pragma unroll
    for (int j = 0; j < 8; ++j) { v4u o; o.x = pk2(v[8 * j], v[8 * j + 1]); o.y = pk2(v[8 * j + 2], v[8 * j + 3]); o.z = pk2(v[8 * j + 4], v[8 * j + 5]); o.w = pk2(v[8 * j + 6], v[8 * j + 7]);
        *(v4u*)(dst + 8 * j) = o; }
}
__device__ __forceinline__ float row_to_bf16(const float* xrow, bf16* orow, const float* w, bool norm, int lane) {
    const f32x4* xr = (const f32x4*)xrow + lane;
    f32x4 v[4]; float s = 0.f;
#pragma unroll
    for (int j = 0; j < 4; ++j) { v[j] = __builtin_nontemporal_load(xr + 64 * j); s += (v[j].x * v[j].x + v[j].y * v[j].y) + (v[j].z * v[j].z + v[j].w * v[j].w); }
    s = wave_sum(s);
    if (norm) { const float r = 1.0f / sqrtf(s * (1.0f / 1024.0f) + EPS);
#pragma unroll
        for (int j = 0; j < 4; ++j) { const f32x4 wv = ((const f32x4*)w)[lane + 64 * j]; v[j] = v[j] * r * wv; } }
    unsigned long long* o8 = (unsigned long long*)orow + lane;
#pragma unroll
    for (int j = 0; j < 4; ++j) o8[64 * j] = (unsigned long long)pk2(v[j].x, v[j].y) | ((unsigned long long)pk2(v[j].z, v[j].w) << 32);
    return s;
}

#define XB_TMO      128
#define XB_XCNT(j)  (256  + 64 * (j))
#define XB_XSUB(j)  (1280 + 64 * (j))
#define XB_XGEN(j)  (2304 + 64 * (j))
#define XB_TOP      3328
#define XB_TOPGEN   3392
#define XCD_BAR_WORDS 3456
#define XB_SPIN_CAP (1u << 18)

__device__ __forceinline__ unsigned xb_ld(unsigned* p)              { return __hip_atomic_load(p, __ATOMIC_RELAXED, __HIP_MEMORY_SCOPE_AGENT); }
__device__ __forceinline__ unsigned xb_add(unsigned* p, unsigned v) { return __hip_atomic_fetch_add(p, v, __ATOMIC_RELAXED, __HIP_MEMORY_SCOPE_AGENT); }
__device__ __forceinline__ unsigned xb_xcc_id() { return (unsigned)__builtin_amdgcn_s_getreg((3 << 11) | 20) & 0xFu; }
#define XB_SPIN(cond, bar) do { unsigned _sp = 0; while (cond) { __builtin_amdgcn_s_sleep(1); \
    if ((++_sp & 255u) == 0u) { if (xb_ld(&(bar)[XB_TMO])) break; if (_sp > XB_SPIN_CAP) { atomicAdd(&(bar)[XB_TMO], 1u); break; } } } } while (0)

struct XcdBarrier {
    unsigned* bar; unsigned x; bool leader;
    volatile LAS unsigned* st;
};

__device__ __forceinline__ XcdBarrier xcd_barrier_post(unsigned* bar, volatile LAS unsigned* st, bool leader) {
    XcdBarrier b; b.bar = bar; b.x = xb_xcc_id(); b.st = st; b.leader = leader;
    if (leader) (void)xb_add(&bar[XB_XCNT(b.x)], 1u);
    return b;
}
__device__ __forceinline__ void xcd_barrier_complete(unsigned* bar, unsigned x, unsigned& nloc, unsigned& nx) {
    const unsigned G = gridDim.x * gridDim.y * gridDim.z;
    unsigned sum, cnt, mine, sp = 0u;
    for (;;) {
        sum = 0u; cnt = 0u; mine = 0u;
#pragma unroll
        for (unsigned j = 0; j < 16; ++j) { const unsigned c = xb_ld(&bar[XB_XCNT(j)]); sum += c; cnt += (c > 0u) ? 1u : 0u; mine = (j == x) ? c : mine; }
        if (sum == G) break;
        __builtin_amdgcn_s_sleep(1);
        if ((++sp & 255u) == 0u) { if (xb_ld(&bar[XB_TMO])) break; if (sp > XB_SPIN_CAP) { atomicAdd(&bar[XB_TMO], 1u); break; } }
    }
    nloc = mine > 0u ? mine : 1u; nx = cnt > 0u ? cnt : 1u;
}

__device__ __forceinline__ void xcd_barrier(const XcdBarrier& b) {
    asm volatile("s_waitcnt vmcnt(0)" ::: "memory");
    __syncthreads();
    if (b.leader) {
        unsigned* bar = b.bar;
        __builtin_amdgcn_s_waitcnt(0);
        unsigned nloc = b.st[0], nx = b.st[1];
        if (nloc == 0u) { xcd_barrier_complete(bar, b.x, nloc, nx); b.st[0] = nloc; b.st[1] = nx; }
        const unsigned old = xb_add(&bar[XB_XSUB(b.x)], 1u);
        const unsigned gen = old / nloc;
        if (old + 1u == (gen + 1u) * nloc) {
            __builtin_amdgcn_fence(__ATOMIC_RELEASE, "agent");
            asm volatile("s_waitcnt vmcnt(0)" ::: "memory");
            const unsigned og = xb_add(&bar[XB_TOP], 1u);
            const unsigned tg = og / nx;
            if (og + 1u == (tg + 1u) * nx) xb_add(&bar[XB_TOPGEN], 1u);
            else XB_SPIN(xb_ld(&bar[XB_TOPGEN]) == tg, bar);
            __builtin_amdgcn_fence(__ATOMIC_ACQUIRE, "agent");
            xb_add(&bar[XB_XGEN(b.x)], 1u);
            asm volatile("s_waitcnt vmcnt(0)" ::: "memory");
        } else {
            XB_SPIN(xb_ld(&bar[XB_XGEN(b.x)]) == gen, bar);
            __builtin_amdgcn_fence(__ATOMIC_ACQUIRE, "agent");
            asm volatile("s_waitcnt vmcnt(0)" ::: "memory");
        }
    }
    __syncthreads();
}


namespace att {
typedef short bf16x8 __attribute__((ext_vector_type(8)));
typedef short s16x4 __attribute__((ext_vector_type(4)));
typedef float f32x16 __attribute__((ext_vector_type(16)));
typedef float f32x2_t __attribute__((ext_vector_type(2)));
typedef __bf16 bf16x2_t __attribute__((ext_vector_type(2)));
#define ALDS __attribute__((address_space(3)))
typedef ALDS unsigned char* ldsp;
constexpr float LOG2E = 1.4426950408889634f;

__device__ __forceinline__ unsigned off_b(unsigned row, unsigned ch) { return 256u * row + 16u * (ch ^ (((row & 3u) << 2) | ((row >> 2) & 3u))); }
__device__ __forceinline__ unsigned cvtpk(float lo, float hi) { f32x2_t v = {lo, hi}; bf16x2_t b = __builtin_convertvector(v, bf16x2_t); return __builtin_bit_cast(unsigned, b); }
__device__ __forceinline__ s16x4 vtr(ldsp p) { typedef short v4i16_t __attribute__((ext_vector_type(4))); return __builtin_bit_cast(s16x4, __builtin_amdgcn_ds_read_tr16_b64_v4i16((ALDS v4i16_t*)p)); }
#define TR_ISSUE(dst, addr, OFF) dst = vtr((ldsp)(size_t)((addr) + (unsigned)(OFF)))
template <int N> __device__ __forceinline__ void tr_wait(s16x4 (&lo)[N], s16x4 (&hi)[N]) {}
__device__ __forceinline__ void dma16(const void* g, ldsp l) {
    unsigned keep; const unsigned d = (unsigned)__builtin_amdgcn_readfirstlane((int)(unsigned)(size_t)l);
    asm volatile("s_mov_b32 %0, m0\n\ts_mov_b32 m0, %2\n\ts_nop 0\n\tglobal_load_lds_dwordx4 %1, off\n\ts_mov_b32 m0, %0" : "=&s"(keep) : "v"(g), "s"(d) : "memory");
}
__device__ __forceinline__ void wait_all_barrier() { asm volatile("s_waitcnt vmcnt(0) lgkmcnt(0)\n\ts_barrier" ::: "memory"); }
__device__ __forceinline__ float wave_max(float v) {
#pragma unroll
    for (int o = 1; o < 64; o <<= 1) v = fmaxf(v, shx(v, o));
    return v;
}
__device__ __forceinline__ bf16x8 pack8s(const f32x16& s, int b) {
    typedef unsigned u4 __attribute__((ext_vector_type(4)));
    u4 w; w.x = cvtpk(s[b], s[b + 1]); w.y = cvtpk(s[b + 2], s[b + 3]); w.z = cvtpk(s[b + 4], s[b + 5]); w.w = cvtpk(s[b + 6], s[b + 7]);
    return __builtin_bit_cast(bf16x8, w);
}
struct LaneAddr { unsigned kb[4]; unsigned vb[8]; };
template <int NET>
__device__ __forceinline__ void lane_addr(LaneAddr& A, int kch0, int vch0, int lane) {
    const unsigned r = lane & 31, hh = lane >> 5, blk = (lane >> 4) & 1, qq = (lane & 15) >> 2, p = lane & 3;
    const unsigned lk = hh ^ (((r & 3u) << 2) | ((r >> 2) & 3u));
#pragma unroll
    for (int ks = 0; ks < 4; ++ks) A.kb[ks] = 256u * r + 16u * (((unsigned)kch0 + 2u * ks) ^ lk);
    const unsigned lv = ((2u * blk) | (p >> 1)) ^ ((qq << 2) | hh);
#pragma unroll
    for (int et = 0; et < NET; ++et)
#pragma unroll
        for (int t = 0; t < 2; ++t) A.vb[2 * et + t] = 256u * (4u * hh + qq) + 8u * (p & 1u) + 16u * ((((unsigned)vch0 + 4u * et) ^ (2u * t)) ^ lv);
}
template <int NET, bool BIAS>
__device__ __forceinline__ void attn_tile(f32x16 (&o)[NET], float& lsum, const bf16x8 (&qf)[4], const LaneAddr& A, unsigned kimg, unsigned vimg, float nslope2, float negM0, float dt) {
    bf16x8 kf[2][4];
#pragma unroll
    for (int ks = 0; ks < 4; ++ks) { const unsigned ka = A.kb[ks] + kimg;
        kf[0][ks] = *(const ALDS bf16x8*)(size_t)(ka); kf[1][ks] = *(const ALDS bf16x8*)(size_t)(ka + 8192u); }
    f32x16 s[2];
#pragma unroll
    for (int sub = 0; sub < 2; ++sub) {
        if (BIAS) { const float d0 = dt - 32.0f * (float)sub;
#pragma unroll
            for (int i = 0; i < 16; ++i) s[sub][i] = fmaf(nslope2, fabsf(d0 - (float)((i & 3) + 8 * (i >> 2))), negM0);
        } else {
#pragma unroll
            for (int i = 0; i < 16; ++i) s[sub][i] = negM0;
        }
    }
#pragma unroll
    for (int ks = 0; ks < 4; ++ks) { s[0] = __builtin_amdgcn_mfma_f32_32x32x16_bf16(kf[0][ks], qf[ks], s[0], 0, 0, 0); s[1] = __builtin_amdgcn_mfma_f32_32x32x16_bf16(kf[1][ks], qf[ks], s[1], 0, 0, 0); }
    unsigned va[NET][2];
#pragma unroll
    for (int et = 0; et < NET; ++et) { va[et][0] = A.vb[2 * et] + vimg; va[et][1] = A.vb[2 * et + 1] + vimg; }
    s16x4 vlo[2][NET], vhi[2][NET];
#pragma unroll
    for (int et = 0; et < NET; ++et) { TR_ISSUE(vlo[0][et], va[et][0], 0); TR_ISSUE(vhi[0][et], va[et][1], 2048); }
    bf16x8 pa[2][2];
#pragma unroll
    for (int sub = 0; sub < 2; ++sub) {
#pragma unroll
        for (int i = 0; i < 16; ++i) { s[sub][i] = __builtin_amdgcn_exp2f(s[sub][i]); lsum += s[sub][i]; }
        pa[sub][0] = pack8s(s[sub], 0); pa[sub][1] = pack8s(s[sub], 8);
    }
    tr_wait<NET>(vlo[0], vhi[0]);
    __builtin_amdgcn_sched_barrier(0);
#pragma unroll
    for (int step = 0; step < 4; ++step) {
        const int cur = step & 1, nxt = cur ^ 1;
        if (step < 3) {
#pragma unroll
            for (int et = 0; et < NET; ++et) { TR_ISSUE(vlo[nxt][et], va[et][0], 256 * (32 * ((step + 1) >> 1) + 16 * ((step + 1) & 1))); TR_ISSUE(vhi[nxt][et], va[et][1], 256 * (32 * ((step + 1) >> 1) + 16 * ((step + 1) & 1)) + 2048); } }
#pragma unroll
        for (int et = 0; et < NET; ++et) {
            const bf16x8 vf = (bf16x8){vlo[cur][et][0], vlo[cur][et][1], vlo[cur][et][2], vlo[cur][et][3], vhi[cur][et][0], vhi[cur][et][1], vhi[cur][et][2], vhi[cur][et][3]};
            o[et] = __builtin_amdgcn_mfma_f32_32x32x16_bf16(vf, pa[step >> 1][step & 1], o[et], 0, 0, 0);
        }
        if (step < 3) tr_wait<NET>(vlo[nxt], vhi[nxt]);
        __builtin_amdgcn_sched_barrier(0);
    }
}

#define MF32(acc, a, b) acc = __builtin_amdgcn_mfma_f32_32x32x16_bf16(a, b, acc, 0, 0, 0)
#define SBAR0() __builtin_amdgcn_sched_barrier(0)
#define VFRAG(buf, et) (bf16x8){vlo[buf][et][0], vlo[buf][et][1], vlo[buf][et][2], vlo[buf][et][3], vhi[buf][et][0], vhi[buf][et][1], vhi[buf][et][2], vhi[buf][et][3]}
__device__ __forceinline__ void bias_tile(f32x16 (&s)[2], float nslope2, float negM0, float dt) {
#pragma unroll
    for (int sub = 0; sub < 2; ++sub) { const float d0 = dt - 32.0f * (float)sub;
#pragma unroll
        for (int i = 0; i < 16; ++i) s[sub][i] = fmaf(nslope2, fabsf(d0 - (float)((i & 3) + 8 * (i >> 2))), negM0); }
}
__device__ __forceinline__ void bias_tile_past(f32x16 (&s)[2], float nslope2, float negM0, float dt) {
    const float slope2 = -nslope2;
#pragma unroll
    for (int sub = 0; sub < 2; ++sub) { const float cb = fmaf(nslope2, dt - 32.0f * (float)sub, negM0);
#pragma unroll
        for (int i = 0; i < 16; ++i) asm("v_fmamk_f32 %0, %1, %3, %2" : "=v"(s[sub][i]) : "v"(slope2), "v"(cb), "i"(__builtin_bit_cast(int, (float)((i & 3) + 8 * (i >> 2))))); }
}
template <bool PAST, bool PAST1 = PAST>
__device__ __forceinline__ void attn_pair(f32x16 (&o)[4], float& lsum, const bf16x8 (&qf)[4], const LaneAddr& A, unsigned k0, unsigned v0, unsigned k1, unsigned v1, float nslope2, float negM0, float dt0, float dt1) {
    bf16x8 kf[2][4];
    f32x16 s0[2], s1[2];
    bf16x8 pa0[2][2], pa1[2][2];
    s16x4 vlo[2][4], vhi[2][4];
#pragma unroll
    for (int ks = 0; ks < 4; ++ks) { const unsigned ka = A.kb[ks] + k0; kf[0][ks] = *(const ALDS bf16x8*)(size_t)(ka); kf[1][ks] = *(const ALDS bf16x8*)(size_t)(ka + 8192u); }
    if (PAST) bias_tile_past(s0, nslope2, negM0, dt0); else bias_tile(s0, nslope2, negM0, dt0);
#pragma unroll
    for (int ks = 0; ks < 4; ++ks) { MF32(s0[0], kf[0][ks], qf[ks]); MF32(s0[1], kf[1][ks], qf[ks]); }
    SBAR0();
    if (PAST1) bias_tile_past(s1, nslope2, negM0, dt1); else bias_tile(s1, nslope2, negM0, dt1);
    unsigned va0[4][2];
#pragma unroll
    for (int et = 0; et < 4; ++et) { va0[et][0] = A.vb[2 * et] + v0; va0[et][1] = A.vb[2 * et + 1] + v0; }
    bf16x8 k2[2][2];
    { const unsigned ka = A.kb[0] + k1; k2[0][0] = *(const ALDS bf16x8*)(size_t)(ka); k2[0][1] = *(const ALDS bf16x8*)(size_t)(ka + 8192u); }
    SBAR0();
#pragma unroll
    for (int g = 0; g < 8; ++g) {
        const int ks = g >> 1, sub = g & 1;
        if (sub == 0 && ks < 3) { const unsigned ka = A.kb[ks + 1] + k1; k2[(ks + 1) & 1][0] = *(const ALDS bf16x8*)(size_t)(ka); k2[(ks + 1) & 1][1] = *(const ALDS bf16x8*)(size_t)(ka + 8192u); }
        MF32(s1[sub], k2[ks & 1][sub], qf[ks]);
#pragma unroll
        for (int k = 0; k < 4; ++k) { const int idx = 4 * g + k; s0[idx >> 4][idx & 15] = __builtin_amdgcn_exp2f(s0[idx >> 4][idx & 15]); lsum += s0[idx >> 4][idx & 15]; }
        if (g & 1) pa0[g >> 2][(g >> 1) & 1] = pack8s(s0[g >> 2], 8 * ((g >> 1) & 1));
        if (g == 6) {
#pragma unroll
            for (int et = 0; et < 4; ++et) { TR_ISSUE(vlo[0][et], va0[et][0], 0); TR_ISSUE(vhi[0][et], va0[et][1], 2048); } }
        SBAR0();
    }
    tr_wait<4>(vlo[0], vhi[0]);
    SBAR0();
    unsigned va1[4][2];
#pragma unroll
    for (int g = 0; g < 16; ++g) {
        const int step = g >> 2, et = g & 3, cur = step & 1, nxt = cur ^ 1;
        if (et == 0) {
            if (step < 3) {
#pragma unroll
                for (int e2 = 0; e2 < 4; ++e2) { TR_ISSUE(vlo[nxt][e2], va0[e2][0], 256 * (32 * ((step + 1) >> 1) + 16 * ((step + 1) & 1))); TR_ISSUE(vhi[nxt][e2], va0[e2][1], 256 * (32 * ((step + 1) >> 1) + 16 * ((step + 1) & 1)) + 2048); }
            } else {
#pragma unroll
                for (int e2 = 0; e2 < 4; ++e2) { va1[e2][0] = A.vb[2 * e2] + v1; va1[e2][1] = A.vb[2 * e2 + 1] + v1; TR_ISSUE(vlo[nxt][e2], va1[e2][0], 0); TR_ISSUE(vhi[nxt][e2], va1[e2][1], 2048); }
            }
        }
        MF32(o[et], VFRAG(cur, et), pa0[step >> 1][step & 1]);
#pragma unroll
        for (int k = 0; k < 2; ++k) { const int idx = 2 * g + k; s1[idx >> 4][idx & 15] = __builtin_amdgcn_exp2f(s1[idx >> 4][idx & 15]); lsum += s1[idx >> 4][idx & 15]; }
        if (et == 3) { pa1[step >> 1][step & 1] = pack8s(s1[step >> 1], 8 * (step & 1)); tr_wait<4>(vlo[nxt], vhi[nxt]); }
        SBAR0();
    }
    if (PROBE == 7) { float dmy = negM0;
#pragma unroll
        for (int i = 0; i < 64; ++i) asm volatile("v_exp_f32 %0, %0" : "+v"(dmy)); }
    if (PROBE == 8) { s16x4 dm;
#pragma unroll
        for (int i = 0; i < 64; ++i) asm volatile("ds_read_b64_tr_b16 %0, %1 offset:%c2" : "=&v"(dm) : "v"(va1[i & 3][0]), "i"((i >> 2) * 512) : "memory");
        asm volatile("s_waitcnt lgkmcnt(0)" ::: "memory"); }
#pragma unroll
    for (int step = 0; step < 4; ++step) {
        const int cur = step & 1, nxt = cur ^ 1;
        if (step < 3) {
#pragma unroll
            for (int e2 = 0; e2 < 4; ++e2) { TR_ISSUE(vlo[nxt][e2], va1[e2][0], 256 * (32 * ((step + 1) >> 1) + 16 * ((step + 1) & 1))); TR_ISSUE(vhi[nxt][e2], va1[e2][1], 256 * (32 * ((step + 1) >> 1) + 16 * ((step + 1) & 1)) + 2048); } }
#pragma unroll
        for (int et = 0; et < 4; ++et) MF32(o[et], VFRAG(cur, et), pa1[step >> 1][step & 1]);
        if (step < 3) tr_wait<4>(vlo[nxt], vhi[nxt]);
        SBAR0();
    }
}

constexpr int N_DIFF_ITEMS = 768, N_MEM_ITEMS = 256;
constexpr int XCH_OFF = 65536, CTL_OFF = 131072;

__device__ __forceinline__ int diff_item(ldsp lds, int qt, int bh, bool pre, unsigned* nctr, const bf16* U, bf16* O, const float* subw, float lam, float omlinit, float M0, int wave, int lane) {
    const int b = bh / 6, h = bh % 6;
    const int c = wave >> 2, wq = wave & 3, r = lane & 31, hh = lane >> 5;
    const size_t tokbase = (size_t)b * SEQ; const int t0 = 128 * qt + 32 * wq;
    bf16x8 qf[4];
    { const bf16* qp = U + (tokbase + t0 + r) * INW + h * 128 + c * 64 + 8 * hh;
#pragma unroll
      for (int ks = 0; ks < 4; ++ks) qf[ks] = *(const bf16x8*)(qp + 16 * ks); }
    f32x16 o[4];
#pragma unroll
    for (int et = 0; et < 4; ++et)
#pragma unroll
        for (int i = 0; i < 16; ++i) o[et][i] = 0.f;
    float lsum = 0.f;
    const float nslope2 = -exp2f(-8.0f * (float)(h + 1) / 6.0f) * LOG2E;
    const int jmax = 2 * qt + (wq >> 1);
    const unsigned lds0 = (unsigned)(size_t)lds; LaneAddr LA; lane_addr<4>(LA, 8 * c, 0, lane);
    const int prow = lane >> 4, chp = lane & 15;
    const bf16* kvsrc[4]; int pofs[4];
#pragma unroll
    for (int i = 0; i < 4; ++i) { const int pi = wave * 4 + i, row = 4 * pi + prow; const unsigned ch = (unsigned)chp ^ (((unsigned)prow << 2) | ((unsigned)pi & 3u));
        kvsrc[i] = U + (tokbase + row) * INW + 768 + h * 128 + ch * 8; pofs[i] = 1024 * pi; }
#define LOAD_PAIR(stage, s0) do { _Pragma("unroll") for (int i_ = 0; i_ < 4; ++i_) { const bf16* src_ = kvsrc[i_] + (size_t)(s0) * INW; \
        dma16(src_, lds + (stage) + pofs[i_]); dma16(src_ + 768, lds + (stage) + 32768 + pofs[i_]); } } while (0)
    if (!pre) LOAD_PAIR(0, 0);
    wait_all_barrier();
    for (int p = 0; p < qt; ++p) {
        const int stage = (p & 1) * 65536;
        LOAD_PAIR(((p + 1) & 1) * 65536, 128 * (p + 1)); if (PROBE == 6) LOAD_PAIR(((p + 1) & 1) * 65536, 128 * (p + 1));
        attn_pair<true>(o, lsum, qf, LA, lds0 + stage, lds0 + stage + 32768, lds0 + stage + 16384, lds0 + stage + 32768 + 16384, nslope2, -M0, (float)(t0 + r - 128 * p - 4 * hh), (float)(t0 + r - 128 * p - 64 - 4 * hh));
        wait_all_barrier();
    }
    {
        const int stage = (qt & 1) * 65536;
        unsigned nt = 0u; if (wave == 0 && lane == 0) nt = atomicAdd(nctr, 1u);
        if (wq >= 2) attn_pair<true, false>(o, lsum, qf, LA, lds0 + stage, lds0 + stage + 32768, lds0 + stage + 16384, lds0 + stage + 32768 + 16384, nslope2, -M0, (float)(t0 + r - 128 * qt - 4 * hh), (float)(t0 + r - 128 * qt - 64 - 4 * hh));
        else attn_tile<4, true>(o, lsum, qf, LA, lds0 + stage, lds0 + stage + 32768, nslope2, -M0, (float)(t0 + r - 128 * qt - 4 * hh));
        if (wave == 0 && lane == 0) ((ALDS unsigned*)(lds + CTL_OFF))[3] = nt;
        wait_all_barrier();
    }
#undef LOAD_PAIR
    const int nli = __builtin_amdgcn_readfirstlane((int)((ALDS unsigned*)(lds + CTL_OFF))[3]);
    if (nli < 96) {
        const int nbh = (bh & 7) + 8 * (nli % 3), nb = nbh / 6, nh = nbh % 6;
#pragma unroll
        for (int i = 0; i < 4; ++i) { const int pi = wave * 4 + i, row = 4 * pi + prow; const unsigned ch = (unsigned)chp ^ (((unsigned)prow << 2) | ((unsigned)pi & 3u));
            const bf16* src = U + ((size_t)nb * SEQ + row) * INW + 768 + nh * 128 + ch * 8;
            dma16(src, lds + 1024 * pi); dma16(src + 768, lds + 32768 + 1024 * pi); }
    }
    int lane_e = lane; asm volatile("" : "+v"(lane_e));
    const int r_e = lane_e & 31, hh_e = lane_e >> 5;
    const float l = lsum + shx(lsum, 32);
    ALDS float* xp = (ALDS float*)(lds + XCH_OFF + wq * 16384);
    if (c == 1) { const float inv = lam / l;
#pragma unroll
        for (int et = 0; et < 4; ++et)
#pragma unroll
            for (int i = 0; i < 16; ++i) xp[(et * 16 + i) * 64 + lane_e] = o[et][i] * inv; }
    asm volatile("s_waitcnt lgkmcnt(0)\n\ts_barrier" ::: "memory");
    if (c == 0) { const float inv = 1.0f / l; float ssq = 0.f;
#pragma unroll
        for (int et = 0; et < 4; ++et)
#pragma unroll
            for (int i = 0; i < 16; ++i) { const float d = o[et][i] * inv - xp[(et * 16 + i) * 64 + lane_e]; o[et][i] = d; ssq += d * d; }
        ssq += shx(ssq, 32);
        const float rs = omlinit / sqrtf(ssq * (1.0f / 128.0f) + EPS);
        bf16* op = O + (tokbase + t0 + r_e) * D + h * 128 + 4 * hh_e;
        const float* swp = subw; asm volatile("" : "+s"(swp));
#pragma unroll
        for (int et = 0; et < 4; ++et)
#pragma unroll
            for (int g4 = 0; g4 < 4; ++g4) { const int e0 = 32 * et + 8 * g4; const f32x4 w = *(const f32x4*)(swp + e0 + 4 * hh_e);
                v2u pk; pk.x = cvtpk(o[et][4 * g4] * rs * w[0], o[et][4 * g4 + 1] * rs * w[1]); pk.y = cvtpk(o[et][4 * g4 + 2] * rs * w[2], o[et][4 * g4 + 3] * rs * w[3]);
                *(v2u*)(op + e0) = pk; }
    }
    return nli;
}
__device__ __forceinline__ void mem_item(ldsp lds, int idx, const bf16* U, const bf16* MKVl, bf16* O, float M0, int wave, int lane) {
    const int bhm = idx >> 4, qb = idx & 15, b = bhm >> 2, hm = bhm & 3;
    const int r = lane & 31, hh = lane >> 5;
    const size_t tokbase = (size_t)b * SEQ; const int t0 = 256 * qb + 32 * wave;
    const int prow = lane >> 4, chp = lane & 15;
#pragma unroll
    for (int i = 0; i < 8; ++i) { const int pi = wave * 8 + i, row = 4 * pi + prow; const unsigned ch = (unsigned)chp ^ (((unsigned)prow << 2) | ((unsigned)pi & 3u));
        const bf16* src = MKVl + (size_t)(b * 256 + row) * 512 + hm * 64 + (ch < 8u ? ch * 8u : 256u + (ch - 8u) * 8u);
        dma16(src, lds + 1024 * pi); }
    bf16x8 qf[4];
    { const bf16* qp = U + (tokbase + t0 + r) * INW + 2304 + hm * 64 + 8 * hh;
#pragma unroll
      for (int ks = 0; ks < 4; ++ks) qf[ks] = *(const bf16x8*)(qp + 16 * ks); }
    f32x16 o[2];
#pragma unroll
    for (int et = 0; et < 2; ++et)
#pragma unroll
        for (int i = 0; i < 16; ++i) o[et][i] = 0.f;
    float lsum = 0.f;
    const unsigned lds0 = (unsigned)(size_t)lds; LaneAddr LA; lane_addr<2>(LA, 0, 8, lane);
    wait_all_barrier();
#pragma unroll 1
    for (int j = 0; j < 4; ++j) attn_tile<2, false>(o, lsum, qf, LA, lds0 + j * 16384, lds0 + j * 16384, 0.f, -M0, 0.f);
    const float inv = 1.0f / (lsum + shx(lsum, 32));
    bf16* op = O + (tokbase + t0 + r) * D + MAINW + hm * 64 + 4 * hh;
#pragma unroll
    for (int et = 0; et < 2; ++et)
#pragma unroll
        for (int g4 = 0; g4 < 4; ++g4) { const int e0 = 32 * et + 8 * g4;
            v2u pk; pk.x = cvtpk(o[et][4 * g4] * inv, o[et][4 * g4 + 1] * inv); pk.y = cvtpk(o[et][4 * g4 + 2] * inv, o[et][4 * g4 + 3] * inv);
            *(v2u*)(op + e0) = pk; }
}
}


namespace ret {
using namespace att;
constexpr int N_ITEMS = BATCH * 64 * 6;
constexpr int STAGE = 49152;
constexpr int RED_OFF = 2 * STAGE;

__device__ __forceinline__ bf16x8 tr_nat(unsigned img, int c, int ks, int lane) {
    const unsigned hh = lane >> 5, blk = (lane >> 4) & 1, qq = (lane & 15) >> 2, p = lane & 3;
    const unsigned row0 = 16u * ks + 8u * hh + qq, ch = 4u * c + 2u * blk + (p >> 1);
    const s16x4 lo = vtr((ldsp)(size_t)(img + off_b(row0, ch) + 8u * (p & 1u))), hi = vtr((ldsp)(size_t)(img + off_b(row0 + 4u, ch) + 8u * (p & 1u)));
    return (bf16x8){lo[0], lo[1], lo[2], lo[3], hi[0], hi[1], hi[2], hi[3]};
}
__device__ __forceinline__ bf16x8 tr_perm(unsigned img, int c, int sub, int st, int lane) {
    const unsigned hh = lane >> 5, blk = (lane >> 4) & 1, qq = (lane & 15) >> 2, p = lane & 3;
    const unsigned row0 = 32u * sub + 16u * st + 4u * hh + qq, ch = 4u * c + 2u * blk + (p >> 1);
    const s16x4 lo = vtr((ldsp)(size_t)(img + off_b(row0, ch) + 8u * (p & 1u))), hi = vtr((ldsp)(size_t)(img + off_b(row0 + 8u, ch) + 8u * (p & 1u)));
    return (bf16x8){lo[0], lo[1], lo[2], lo[3], hi[0], hi[1], hi[2], hi[3]};
}
__device__ __forceinline__ float bfs(short v) { return __builtin_bit_cast(float, (unsigned)(unsigned short)v << 16); }
__device__ __forceinline__ void decode(int item, int& b, int& n, int& h) { h = item % 6; const int bn = item / 6; n = bn & 63; b = bn >> 6; }

template <bool WITH_PREV>
__device__ __forceinline__ void stage_item(ldsp lds, int stage, int item, const bf16* U, const bf16* PREV, int wave, int lane) {
    int b, n, h; decode(item, b, n, h);
    const int prow = lane >> 4, chp = lane & 15;
#pragma unroll
    for (int i = 0; i < 2; ++i) { const int pi = wave * 2 + i, row = 4 * pi + prow; const unsigned ch = (unsigned)chp ^ (((unsigned)prow << 2) | ((unsigned)pi & 3u));
        const bf16* urow = U + ((size_t)b * SEQ + 64 * n + row) * INW;
        dma16(urow + (ch < 8u ? 384 + h * 64 + ch * 8 : h * 64 + (ch - 8u) * 8), lds + stage + 1024 * pi);
        dma16(urow + 768 + h * 128 + ch * 8, lds + stage + 16384 + 1024 * pi);
        if (WITH_PREV) dma16(PREV + ((size_t)item * 64 + row) * 128 + ch * 8, lds + stage + 32768 + 1024 * pi); }
}

__device__ __forceinline__ void r1_phase(ldsp lds, const bf16* U, bf16* KV, int G, int bx, int wave, int lane) {
    const unsigned lds0 = (unsigned)(size_t)lds;
    const int dt = wave & 1, et = wave >> 1, r = lane & 31, hh = lane >> 5;
    if (bx < N_ITEMS) stage_item<false>(lds, 0, bx, U, nullptr, wave, lane);
    wait_all_barrier();
    int k = 0;
    for (int item = bx; item < N_ITEMS; item += G, ++k) {
        const unsigned st = lds0 + (k & 1) * STAGE;
        if (item + G < N_ITEMS) stage_item<false>(lds, ((k + 1) & 1) * STAGE, item + G, U, nullptr, wave, lane);
        int b, n, h; decode(item, b, n, h);
        const float lg2 = log2f(1.0f - exp2f(-5.0f - (float)h));
        f32x16 acc;
#pragma unroll
        for (int i = 0; i < 16; ++i) acc[i] = 0.f;
#pragma unroll
        for (int ks = 0; ks < 4; ++ks) {
            const bf16x8 kf = tr_nat(st, dt, ks, lane), vf = tr_nat(st + 16384, et, ks, lane);
            float kd[8];
#pragma unroll
            for (int jj = 0; jj < 8; ++jj) kd[jj] = bfs(kf[jj]) * __builtin_amdgcn_exp2f(lg2 * (float)(63 - (16 * ks + 8 * hh + jj)));
            typedef unsigned u4 __attribute__((ext_vector_type(4)));
            u4 w; w.x = cvtpk(kd[0], kd[1]); w.y = cvtpk(kd[2], kd[3]); w.z = cvtpk(kd[4], kd[5]); w.w = cvtpk(kd[6], kd[7]);
            acc = __builtin_amdgcn_mfma_f32_32x32x16_bf16(vf, __builtin_bit_cast(bf16x8, w), acc, 0, 0, 0);
        }
        wait_all_barrier();
        bf16* kvp = KV + ((size_t)item * 64 + 32 * dt + r) * 128 + 32 * et + 4 * hh;
#pragma unroll
        for (int g4 = 0; g4 < 4; ++g4) { v2u pk; pk.x = cvtpk(acc[4 * g4], acc[4 * g4 + 1]); pk.y = cvtpk(acc[4 * g4 + 2], acc[4 * g4 + 3]); *(v2u*)(kvp + 8 * g4) = pk; }
    }
}
__device__ __forceinline__ void r2_phase(const bf16* __restrict__ KV, bf16* __restrict__ PREV, int gtid, int gthreads) {
    for (int idx = gtid; idx < BATCH * 6 * 64 * 64; idx += gthreads) {
        const int e2 = idx & 63, d = (idx >> 6) & 63, bh = idx >> 12, h = bh % 6, b = bh / 6;
        const float cd = exp2f(64.0f * log2f(1.0f - exp2f(-5.0f - (float)h)));
        float s0 = 0.f, s1 = 0.f;
        const size_t base = (((size_t)b * 64 * 6 + h) * 64 + d) * 128 + 2 * e2, nstride = (size_t)6 * 64 * 128;
#pragma unroll 32
        for (int n = 0; n < 64; ++n) {
            const unsigned kvw = *(const unsigned*)(KV + base + n * nstride);
            *(unsigned*)(PREV + base + n * nstride) = cvtpk(s0, s1);
            s0 = s0 * cd + bflo(kvw); s1 = s1 * cd + bfhi(kvw);
        }
    }
}
__device__ __forceinline__ void r3_phase(ldsp lds, const bf16* U, const bf16* PREV, bf16* O, const float* gnw, int G, int bx, int wave, int lane) {
    const unsigned lds0 = (unsigned)(size_t)lds;
    const int it = wave & 1, et = wave >> 1, r = lane & 31, hh = lane >> 5;
    if (bx < N_ITEMS) stage_item<true>(lds, 0, bx, U, PREV, wave, lane);
    wait_all_barrier();
    int k = 0;
    for (int item = bx; item < N_ITEMS; item += G, ++k) {
        const unsigned st = lds0 + (k & 1) * STAGE;
        if (item + G < N_ITEMS) stage_item<true>(lds, ((k + 1) & 1) * STAGE, item + G, U, PREV, wave, lane);
        int b, n, h; decode(item, b, n, h);
        const float lg2 = log2f(1.0f - exp2f(-5.0f - (float)h));
        bf16x8 qf[4];
#pragma unroll
        for (int ks = 0; ks < 4; ++ks) qf[ks] = *(const ALDS bf16x8*)(size_t)(st + off_b(32u * it + r, 8u + 2u * ks + hh));
        bf16x8 pa[2][2];
        const int irow = 32 * it + r;
#pragma unroll
        for (int sub = 0; sub < 2; ++sub) {
            f32x16 s;
#pragma unroll
            for (int i = 0; i < 16; ++i) s[i] = 0.f;
#pragma unroll
            for (int ks = 0; ks < 4; ++ks) { const bf16x8 kf = *(const ALDS bf16x8*)(size_t)(st + off_b(32u * sub + r, 2u * ks + hh)); s = __builtin_amdgcn_mfma_f32_32x32x16_bf16(kf, qf[ks], s, 0, 0, 0); }
#pragma unroll
            for (int i = 0; i < 16; ++i) { const int jrow = 32 * sub + (i & 3) + 8 * (i >> 2) + 4 * hh; s[i] *= __builtin_amdgcn_exp2f(lg2 * fabsf((float)(irow - jrow))); }
            pa[sub][0] = pack8s(s, 0); pa[sub][1] = pack8s(s, 8);
        }
        f32x16 oin, ox;
#pragma unroll
        for (int i = 0; i < 16; ++i) { oin[i] = 0.f; ox[i] = 0.f; }
#pragma unroll
        for (int sub = 0; sub < 2; ++sub)
#pragma unroll
            for (int s2 = 0; s2 < 2; ++s2) oin = __builtin_amdgcn_mfma_f32_32x32x16_bf16(tr_perm(st + 16384, et, sub, s2, lane), pa[sub][s2], oin, 0, 0, 0);
#pragma unroll
        for (int ks = 0; ks < 4; ++ks) ox = __builtin_amdgcn_mfma_f32_32x32x16_bf16(tr_nat(st + 32768, et, ks, lane), qf[ks], ox, 0, 0, 0);
        const float dec = __builtin_amdgcn_exp2f(lg2 * (float)(irow + 1));
        float ssq = 0.f;
#pragma unroll
        for (int i = 0; i < 16; ++i) { oin[i] = fmaf(dec, ox[i], oin[i]); ssq += oin[i] * oin[i]; }
        ssq += shx(ssq, 32);
        ALDS float* red = (ALDS float*)(lds + RED_OFF + (k & 1) * 1024);
        if (hh == 0) red[(et * 2 + it) * 32 + r] = ssq;
        wait_all_barrier();
        const float tot = (red[(0 * 2 + it) * 32 + r] + red[(1 * 2 + it) * 32 + r]) + (red[(2 * 2 + it) * 32 + r] + red[(3 * 2 + it) * 32 + r]);
        const float rs = 1.0f / sqrtf(tot * (1.0f / 128.0f) + EPS);
        const size_t tok = (size_t)b * SEQ + 64 * n + irow;
        const float* gb = gnw; asm volatile("" : "+s"(gb));
        const float* gp = gb + h * 128 + 32 * et + 4 * hh;
        const bf16* gatep = U + tok * INW + 1536 + h * 128 + 32 * et + 4 * hh;
        bf16* op = O + tok * D + h * 128 + 32 * et + 4 * hh;
        f32x4 wq4[4]; v2u gq4[4];
#pragma unroll
        for (int g4 = 0; g4 < 4; ++g4) { wq4[g4] = *(const f32x4*)(gp + 8 * g4); gq4[g4] = *(const v2u*)(gatep + 8 * g4); }
#pragma unroll
        for (int g4 = 0; g4 < 4; ++g4) { const f32x4 w = wq4[g4]; const v2u gt = gq4[g4];
            v2u pk; pk.x = cvtpk(oin[4 * g4] * rs * w[0] * bflo(gt.x), oin[4 * g4 + 1] * rs * w[1] * bfhi(gt.x));
            pk.y = cvtpk(oin[4 * g4 + 2] * rs * w[2] * bflo(gt.y), oin[4 * g4 + 3] * rs * w[3] * bfhi(gt.y));
            *(v2u*)(op + 8 * g4) = pk; }
    }
}
}

typedef const __attribute__((address_space(4))) Args* ArgsP;
__device__ __forceinline__ ArgsP args_ptr() { ArgsP p = (ArgsP)__builtin_amdgcn_kernarg_segment_ptr(); asm volatile("" : "+s"(p)); return p; }
constexpr int XBAR_WORD0 = 4096, XBAR_LDS = 131072 + 64;
#define GRID_BAR() do { XcdBarrier xb_; xb_.bar = (unsigned*)(args_ptr()->ws + WS_CTL) + XBAR_WORD0; xb_.x = xb_xcc_id(); \
        xb_.st = (volatile LAS unsigned*)((LAS unsigned char*)lds + XBAR_LDS); xb_.leader = (wave_s == 0) && (__builtin_amdgcn_mbcnt_hi(~0u, __builtin_amdgcn_mbcnt_lo(~0u, 0u)) == 0u); xcd_barrier(xb_); } while (0)
#define TIDS() int lane_ = (int)__builtin_amdgcn_mbcnt_hi(~0u, __builtin_amdgcn_mbcnt_lo(~0u, 0u)); asm volatile("" : "+v"(lane_)); const int lane = lane_ & 63, wave = wave_s & 7, tid = wave * 64 + lane; const int G = gridDim.x, bx = blockIdx.x; (void)lane; (void)wave; (void)tid; (void)G; (void)bx
#define GIDS() const int gw = bx * NWAVES + wave, ngw = G * NWAVES, gtid = bx * NTHR + tid, gthreads = G * NTHR; (void)gw; (void)ngw; (void)gtid; (void)gthreads

constexpr int I_IN = 16 * 40, I_OUT = 16 * 16, I_GU = 16 * 88, I_DN = 44 * 16, I_MKV = 16 * 8, I_L = I_IN + I_OUT + I_GU + I_DN;
__device__ __forceinline__ void convert_layer(ArgsP a, int L, int first, int stride, int lane) {
    unsigned char* ws = a->ws;
    bf16* WIN = (bf16*)(ws + WS_WIN); bf16* WOUT = (bf16*)(ws + WS_WOUT); bf16* WGU = (bf16*)(ws + WS_WGU); bf16* WDN = (bf16*)(ws + WS_WDN);
    for (int r = first; r < I_L; r += stride) {
        if (r < I_IN) transpose_item(a->in[3] + (size_t)L * D * INW, D, INW, WIN + (size_t)(L & 1) * INW * D, a->in[2] + L * D, 1, 0, r, lane);
        else if (r < I_IN + I_OUT) transpose_item(a->in[4] + (size_t)L * D * D, D, D, WOUT + (size_t)(L & 1) * D * D, nullptr, 0, 0, r - I_IN, lane);
        else if (r < I_IN + I_OUT + I_GU) transpose_item(a->in[18] + (size_t)L * D * GU, D, GU, WGU + (size_t)(L & 1) * GU * D, a->in[17] + L * D, 2, 0, r - I_IN - I_OUT, lane);
        else transpose_item(a->in[19] + (size_t)L * FFN * D, FFN, D, WDN + (size_t)(L & 1) * D * FFN, nullptr, 0, 0, r - I_IN - I_OUT - I_GU, lane);
    }
}
__device__ __forceinline__ void phase_prologue(unsigned char* lds, int wave_s) {
    ArgsP a = args_ptr(); TIDS(); GIDS(); unsigned char* ws = a->ws;
    bf16* WMKV = (bf16*)(ws + WS_WMKV); bf16* MEMN = (bf16*)(ws + WS_MEMN); bf16* XB = (bf16*)(ws + WS_XB); float* SS = (float*)(ws + WS_SS);
    for (int it = gw; it < I_L + DEPTH * I_MKV; it += ngw) {
        if (it < I_L) convert_layer(a, 0, it, 1 << 30, lane);
        else { const int r = it - I_L, L = r / I_MKV; transpose_item(a->in[6] + (size_t)L * D * 512, D, 512, WMKV, nullptr, 1, 512 * L, r % I_MKV, lane); }
    }
    const float* x_in = a->in[0];
    for (int m = gw; m < MEMR; m += ngw) row_to_bf16(a->in[1] + (size_t)m * D, MEMN + (size_t)m * D, a->in[5], true, lane);
    for (int row = gw; row < M; row += 2 * ngw) {
        const int row2 = row + ngw; const bool two = row2 < M;
        const f32x4* x0 = (const f32x4*)(x_in + (size_t)row * D) + lane; const f32x4* x1 = (const f32x4*)(x_in + (size_t)(two ? row2 : row) * D) + lane;
        f32x4 v0[4], v1[4]; float s0 = 0.f, s1 = 0.f;
#pragma unroll
        for (int j = 0; j < 4; ++j) { v0[j] = __builtin_nontemporal_load(x0 + 64 * j); v1[j] = __builtin_nontemporal_load(x1 + 64 * j); }
#pragma unroll
        for (int j = 0; j < 4; ++j) { s0 += (v0[j].x * v0[j].x + v0[j].y * v0[j].y) + (v0[j].z * v0[j].z + v0[j].w * v0[j].w); s1 += (v1[j].x * v1[j].x + v1[j].y * v1[j].y) + (v1[j].z * v1[j].z + v1[j].w * v1[j].w); }
        s0 = wave_sum(s0); s1 = wave_sum(s1);
        unsigned long long* o0 = (unsigned long long*)(XB + (size_t)row * D) + lane;
#pragma unroll
        for (int j = 0; j < 4; ++j) o0[64 * j] = (unsigned long long)pk2(v0[j].x, v0[j].y) | ((unsigned long long)pk2(v0[j].z, v0[j].w) << 32);
        if (lane < 16) SS[(size_t)row * 16 + lane] = lane == 0 ? s0 : 0.f;
        if (two) { unsigned long long* o1 = (unsigned long long*)(XB + (size_t)row2 * D) + lane;
#pragma unroll
            for (int j = 0; j < 4; ++j) o1[64 * j] = (unsigned long long)pk2(v1[j].x, v1[j].y) | ((unsigned long long)pk2(v1[j].z, v1[j].w) << 32);
            if (lane < 16) SS[(size_t)row2 * 16 + lane] = lane == 0 ? s1 : 0.f; }
    }
}
__device__ __forceinline__ void phase_A(unsigned char* lds, int wave_s, int L) {
    ArgsP a = args_ptr(); TIDS(); unsigned char* ws = a->ws; const int j = L >> 1;
    pg8::Gemm g{(bf16*)(ws + WS_XB), (bf16*)(ws + WS_WIN) + (size_t)(L & 1) * INW * D, M, INW, D}; pg8::StaticOrder S; S.init(M, INW, G, bx);
    pg8::EpiU E{(bf16*)(ws + WS_U), (const float*)(ws + WS_SS), L & 1, a->in[10] + j * 64, a->in[11] + j * 64, a->in[7] + L * 64, 0.125f * 1.4426950408889634f};
    pg8::gemm_phase<pg8::EpiU, pg8::StaticOrder, true, true>((pg8::PG8_LAS_T*)lds, g, S, E, tid);
    if (L + 1 < DEPTH && bx >= 128 && bx < 224) convert_layer(args_ptr(), L + 1, (bx - 128) * NWAVES + wave, 96 * NWAVES, lane);
}
__device__ __forceinline__ void phase_MKV(unsigned char* lds, int wave_s) {
    ArgsP a = args_ptr(); TIDS(); unsigned char* ws = a->ws;
    pg8::Gemm g2{(bf16*)(ws + WS_MEMN), (bf16*)(ws + WS_WMKV), MEMR, 2048, D}; pg8::TailOrder T{4, 8, G - 32, bx};
    pg8::EpiMKV E2{(bf16*)(ws + WS_MKV), a->in[8]};
    pg8::gemm_phase<pg8::EpiMKV, pg8::TailOrder, true, true>((pg8::PG8_LAS_T*)lds, g2, T, E2, tid);
}
__device__ __forceinline__ void phase_attn(unsigned char* lds_, int wave_s, int L, int rep = 0) {
    ArgsP a = args_ptr(); TIDS(); unsigned char* ws = a->ws; const int j = L >> 1; const bool diff = (L & 1) != 0;
    att::ldsp lds = (att::ldsp)lds_;
    ALDS unsigned* ctl = (ALDS unsigned*)(lds + att::CTL_OFF);
    unsigned* ctr = (unsigned*)(ws + WS_CTL) + 64 * L + 8 * rep;
    const bf16* U = (const bf16*)(ws + WS_U); bf16* O = (bf16*)(ws + WS_O); const bf16* MKVl = (const bf16*)(ws + WS_MKV) + (size_t)L * MEMR * 512;
    float M0d = 0.f, lam = 0.f, omlinit = 0.f;
    unsigned tk0 = 0u;
    if (diff && tid == 0) tk0 = atomicAdd((unsigned*)(ws + WS_CTL) + 1024 + 512 * L + 4 * rep + 64 * (int)(xb_xcc_id() & 7u), 1u);
    if (diff) {
        const float mq = att::wave_max(fabsf(a->in[10][j * 64 + lane])), mk = att::wave_max(fabsf(a->in[11][j * 64 + lane]));
        M0d = 8.0f * mq * mk * att::LOG2E * 1.05f;
        const float linit = 0.8f - 0.6f * expf(-0.3f * (float)L);
        const float d1 = wave_sum(a->in[12][j * 64 + lane] * a->in[13][j * 64 + lane]), d2 = wave_sum(a->in[14][j * 64 + lane] * a->in[15][j * 64 + lane]);
        lam = expf(d1) - expf(d2) + linit; omlinit = 1.0f - linit;
    }
    const float* subw = a->in[16] + j * 128;
    if (diff) {
        const int myx = (int)(xb_xcc_id() & 7u);
        unsigned* dctr = (unsigned*)(ws + WS_CTL) + 1024 + 512 * L + 4 * rep;
        int q = myx; bool first = true;
        if (wave >= 4) __builtin_amdgcn_s_setprio(1);
        for (;;) {
            if (tid == 0) ctl[0] = first ? tk0 : atomicAdd(dctr + 64 * q, 1u);
            first = false;
            att::wait_all_barrier();
            int li = __builtin_amdgcn_readfirstlane((int)ctl[0]); bool pre = false;
            while (li < 96) { const int nli = att::diff_item(lds, 31 - li / 3, q + 8 * (li % 3), pre, dctr + 64 * q, U, O, subw, lam, omlinit, M0d, wave, lane); pre = nli < 96; li = nli; }
            if (wave == 0) { const unsigned c = lane < 8 ? __hip_atomic_load(dctr + 64 * ((myx + lane) & 7), __ATOMIC_RELAXED, __HIP_MEMORY_SCOPE_AGENT) : 96u;
                const unsigned long long mk = __ballot(c < 96u);
                if (lane == 0) ctl[2] = mk ? (unsigned)((myx + (__ffsll((long long)mk) - 1)) & 7) : 8u; }
            att::wait_all_barrier();
            const int pick = __builtin_amdgcn_readfirstlane((int)ctl[2]);
            if (pick >= 8) break;
            q = pick;
        }
        __builtin_amdgcn_s_setprio(0);
    }
    int lane_m = lane; asm volatile("" : "+v"(lane_m));
    const float M0m = 8.0f * att::wave_max(fabsf(a->in[7][L * 64 + lane_m])) * att::wave_max(fabsf(a->in[8][L * 64 + lane_m])) * att::LOG2E * 1.05f;
    if (!diff) {
        for (int idx = bx; idx < att::N_MEM_ITEMS; idx += G) { att::wait_all_barrier(); att::mem_item(lds, idx, U, MKVl, O, M0m, wave, lane_m); }
    } else for (;;) {
        if (tid == 0) ctl[1] = atomicAdd(ctr + 32, 1u);
        att::wait_all_barrier();
        const int idx = __builtin_amdgcn_readfirstlane((int)ctl[1]);
        if (idx >= att::N_MEM_ITEMS) break;
        att::mem_item(lds, idx, U, MKVl, O, M0m, wave, lane_m);
    }
}
__device__ __forceinline__ void phase_R1(unsigned char* lds, int wave_s, int L) {
    ArgsP a = args_ptr(); TIDS(); unsigned char* ws = a->ws;
    ret::r1_phase((att::ldsp)lds, (const bf16*)(ws + WS_U), (bf16*)(ws + WS_KV), G, bx, wave, lane);
}
__device__ __forceinline__ void phase_R2(unsigned char* lds, int wave_s, int L) {
    ArgsP a = args_ptr(); TIDS(); GIDS(); unsigned char* ws = a->ws;
    ret::r2_phase((const bf16*)(ws + WS_KV), (bf16*)(ws + WS_KV + 24 * MiB), gtid, gthreads);
}
__device__ __forceinline__ void phase_R3(unsigned char* lds, int wave_s, int L) {
    ArgsP a = args_ptr(); TIDS(); unsigned char* ws = a->ws; const int j = L >> 1;
    ret::r3_phase((att::ldsp)lds, (const bf16*)(ws + WS_U), (const bf16*)(ws + WS_KV + 24 * MiB), (bf16*)(ws + WS_O), a->in[9] + j * 768, G, bx, wave, lane);
}
__device__ __forceinline__ void phase_C(unsigned char* lds, int wave_s, int L) {
    ArgsP a = args_ptr(); TIDS(); unsigned char* ws = a->ws; float* out = a->out;
    pg8::Gemm g{(bf16*)(ws + WS_O), (bf16*)(ws + WS_WOUT) + (size_t)(L & 1) * D * D, M, D, D}; pg8::StaticOrder S; S.init(M, D, G, bx);
    pg8::EpiRes E{out, (bf16*)(ws + WS_XB), (float*)(ws + WS_SS), 0};
    pg8::gemm_phase<pg8::EpiRes, pg8::StaticOrder, true, true>((pg8::PG8_LAS_T*)lds, g, S, E, tid);
}
__device__ __forceinline__ void phase_D(unsigned char* lds, int wave_s, int L) {
    ArgsP a = args_ptr(); TIDS(); unsigned char* ws = a->ws;
    pg8::Gemm g{(bf16*)(ws + WS_XB), (bf16*)(ws + WS_WGU) + (size_t)(L & 1) * GU * D, M, GU, D}; pg8::StaticOrder S; S.init(M, GU, G, bx);
    pg8::EpiSwi E{(bf16*)(ws + WS_ACT), (const float*)(ws + WS_SS)};
    pg8::gemm_phase<pg8::EpiSwi, pg8::StaticOrder, true, true>((pg8::PG8_LAS_T*)lds, g, S, E, tid);
}
__device__ __forceinline__ void phase_E(unsigned char* lds, int wave_s, int L) {
    ArgsP a = args_ptr(); TIDS(); unsigned char* ws = a->ws; float* out = a->out;
    pg8::Gemm g{(bf16*)(ws + WS_ACT), (bf16*)(ws + WS_WDN) + (size_t)(L & 1) * D * FFN, M, D, FFN}; pg8::StaticOrder S; S.init(M, D, G, bx);
    pg8::EpiRes E{out, (bf16*)(ws + WS_XB), (float*)(ws + WS_SS), L == DEPTH - 1 ? 1 : 0};
    pg8::gemm_phase<pg8::EpiRes, pg8::StaticOrder, true, true>((pg8::PG8_LAS_T*)lds, g, S, E, tid);
}

__global__ void __launch_bounds__(NTHR, 2) fwd_megakernel(Args a_unused) {
    extern __shared__ __attribute__((aligned(16))) unsigned char lds[];
    cg::grid_group grid = cg::this_grid();
    const int wave_s = __builtin_amdgcn_readfirstlane((int)threadIdx.x >> 6);
    if (threadIdx.x < 2) ((LAS unsigned*)((LAS unsigned char*)lds + XBAR_LDS))[threadIdx.x] = 0u;
    __syncthreads();
    if (blockIdx.x == 0) { unsigned* cw = (unsigned*)(args_ptr()->ws + WS_CTL); for (int i = threadIdx.x; i < 16384; i += NTHR) cw[i] = 0u; }
    phase_prologue(lds, wave_s);
    if (PROBE == 1) phase_prologue(lds, wave_s);
    grid.sync();
    (void)xcd_barrier_post((unsigned*)(args_ptr()->ws + WS_CTL) + XBAR_WORD0, (volatile LAS unsigned*)((LAS unsigned char*)lds + XBAR_LDS),
                           (wave_s == 0) && (__builtin_amdgcn_mbcnt_hi(~0u, __builtin_amdgcn_mbcnt_lo(~0u, 0u)) == 0u));
    phase_MKV(lds, wave_s);
#define LAYER(L) do { \
        phase_A(lds, wave_s, L); \
        if (PROBE == 4) phase_A(lds, wave_s, L); \
        GRID_BAR(); \
        if (!((L) & 1)) { phase_R1(lds, wave_s, L); phase_attn(lds, wave_s, L); GRID_BAR(); phase_R2(lds, wave_s, L); GRID_BAR(); phase_R3(lds, wave_s, L); \
            if (PROBE == 3) { GRID_BAR(); phase_R1(lds, wave_s, L); GRID_BAR(); phase_R2(lds, wave_s, L); GRID_BAR(); phase_R3(lds, wave_s, L); } } \
        else { phase_attn(lds, wave_s, L); if (PROBE == 2) { GRID_BAR(); phase_attn(lds, wave_s, L, 1); } } \
        GRID_BAR(); \
        phase_C(lds, wave_s, L); \
        GRID_BAR(); \
        if (PROBE == 5) { GRID_BAR(); GRID_BAR(); GRID_BAR(); GRID_BAR(); GRID_BAR(); GRID_BAR(); } \
        phase_D(lds, wave_s, L); \
        if (PROBE == 4) phase_D(lds, wave_s, L); \
        GRID_BAR(); \
        phase_E(lds, wave_s, L); \
        if ((L) + 1 < DEPTH) GRID_BAR(); } while (0)
    LAYER(0); LAYER(1); LAYER(2); LAYER(3);
#undef LAYER
}

extern "C" void kernel_launch(void* const* d_in, const int* in_sizes, int n_in, void* d_out, int out_size, void* d_ws, size_t ws_size, hipStream_t stream) {
    static int grid_blocks = 0;
    if (grid_blocks == 0) {
        if (n_in != 20 || out_size != M * D || ws_size < WS_END) { fprintf(stderr, "kernel_launch: unexpected shapes (n_in %d, out %d, ws %zu)\n", n_in, out_size, ws_size); grid_blocks = -1; return; }
        int dev = 0, cus = 0, per_cu = 0;
        hipGetDevice(&dev);
        hipDeviceGetAttribute(&cus, hipDeviceAttributeMultiprocessorCount, dev);
        hipFuncSetAttribute((const void*)fwd_megakernel, hipFuncAttributeMaxDynamicSharedMemorySize, LDS_BYTES);
        hipOccupancyMaxActiveBlocksPerMultiprocessor(&per_cu, (const void*)fwd_megakernel, NTHR, LDS_BYTES);
        if (per_cu < 1) { fprintf(stderr, "kernel_launch: occupancy query says %d blocks per CU\n", per_cu); grid_blocks = -1; return; }
        grid_blocks = cus;
        fprintf(stderr, "kernel_launch: cus %d per_cu %d grid %d ws %zu\n", cus, per_cu, grid_blocks, ws_size);
    }
    if (grid_blocks < 0) return;
    Args a{};
    for (int i = 0; i < 20; ++i) a.in[i] = (const float*)d_in[i];
    a.out = (float*)d_out; a.ws = (unsigned char*)d_ws;
    void* args[] = {&a};
    hipError_t e = hipLaunchCooperativeKernel((const void*)fwd_megakernel, dim3(grid_blocks), dim3(NTHR), args, LDS_BYTES, stream);
    if (e != hipSuccess) fprintf(stderr, "cooperative launch failed: %s (grid %d)\n", hipGetErrorString(e), grid_blocks);
}
```

```cpp
#include <hip/hip_runtime.h>
#include <hip/hip_cooperative_groups.h>
#include <cstdio>
#include <cstdint>
#define PROBE 0
__device__ __forceinline__ float shx(float v, int o) {
    int l = (int)__builtin_amdgcn_mbcnt_hi(~0u, __builtin_amdgcn_mbcnt_lo(~0u, 0u)); asm volatile("" : "+v"(l));
    return __builtin_bit_cast(float, __builtin_amdgcn_ds_bpermute((l ^ o) << 2, __builtin_bit_cast(int, v)));
}
namespace pg8 {
#define PG8_LAS __attribute__((address_space(3)))
typedef unsigned short bf16_t;
typedef short bf16x8 __attribute__((ext_vector_type(8)));
typedef float f32x4 __attribute__((ext_vector_type(4)));
typedef unsigned u32x4 __attribute__((ext_vector_type(4)));
constexpr int BM = 256, BK = 64, HALF = 128, HTB = HALF * BK * 2  , STAGE_BYTES = 8 * HTB, NXCD = 8, WGM = 8;

__host__ __device__ __forceinline__ int lds_byte(int r, int c) { const int st = (r >> 4) * 2 + (c >> 5), rr = r & 15, cc = c & 31, ob = rr * 64 + cc * 2; return st * 1024 + (ob ^ (((ob >> 9) & 1) << 5)); }
__host__ __device__ __forceinline__ void stage_rc(int b, int& R, int& C) { const int st = b / 1024, sb = b % 1024, swz = sb ^ (((sb >> 9) & 1) << 5); R = (st >> 1) * 16 + swz / 64; C = (st & 1) * 32 + (swz % 64) / 2; }
__host__ __device__ __forceinline__ int perm32(int rho) { const int n = rho >> 4, i = rho & 15; return 8 * (i >> 2) + 4 * n + (i & 3); }

struct Unit { int pm, pn; };
struct Gemm { const bf16_t* A; const bf16_t* Bt; int M, N, K; };

struct StaticOrder {
    int nM, nN, nwg, G, c;
    __host__ __device__ void init(int M, int N, int G_, int c_) { nM = M / BM; nN = N / BM; nwg = nM * nN; G = G_; c = c_; }
    __host__ __device__ bool next(int i, Unit& u) const {
        const long L = (long)i * G + c; if (L >= nwg) return false;
        int wgid = (int)L; { const int q = nwg / NXCD, r = nwg % NXCD, xcd = wgid % NXCD, off = wgid / NXCD; wgid = (xcd < r ? xcd * (q + 1) : r * (q + 1) + (xcd - r) * q) + off; }
        const int nig = WGM * nN, gid = wgid / nig, fm = gid * WGM, gsz = (nM - fm) < WGM ? (nM - fm) : WGM;
        u.pm = fm + ((wgid % nig) % gsz); u.pn = (wgid % nig) / gsz; return true;
    }
    __device__ __forceinline__ void a_ready(const Unit&) const {}
    __device__ __forceinline__ void done(const Unit&) const {}
};

__device__ __forceinline__ unsigned cvt_pk_bf16(float lo, float hi) { unsigned r; asm volatile("v_cvt_pk_bf16_f32 %0, %1, %2" : "=v"(r) : "v"(lo), "v"(hi)); return r; }
typedef float f32x2 __attribute__((ext_vector_type(2)));
typedef PG8_LAS unsigned char PG8_LAS_T;
constexpr float RMS_EPS = 1e-6f;
__device__ __forceinline__ float row_part(const float* ss, int row, int fq) { const f32x4 a = ((const f32x4*)(ss + (size_t)row * 16))[fq]; return (a[0] + a[1]) + (a[2] + a[3]); }
__device__ __forceinline__ float row_finish(float t) { t += shx(t, 16); t += shx(t, 32); return __builtin_amdgcn_rsqf(t * (1.0f / 1024.0f) + RMS_EPS); }
__device__ __forceinline__ float silu_f(float v) { return v * __builtin_amdgcn_rcpf(1.0f + __builtin_amdgcn_exp2f(v * -1.4426950408889634f)); }
__device__ __forceinline__ f32x4 silu4(f32x4 v) { return (f32x4){silu_f(v[0]), silu_f(v[1]), silu_f(v[2]), silu_f(v[3])}; }
__device__ __forceinline__ float sq4(f32x4 v) { return (v[0] * v[0] + v[1] * v[1]) + (v[2] * v[2] + v[3] * v[3]); }
__device__ __forceinline__ u32x4 pack8(f32x4 a, f32x4 b) { u32x4 w; w.x = cvt_pk_bf16(a[0], a[1]); w.y = cvt_pk_bf16(a[2], a[3]); w.z = cvt_pk_bf16(b[0], b[1]); w.w = cvt_pk_bf16(b[2], b[3]); return w; }

struct EpiU {
    static constexpr bool PERM = true, AFTER_DRAIN = false;
    bf16_t* U; const float* ss; int diff; const float *qw, *kw, *mqw; float qscale;
    __device__ __forceinline__ void operator()(const f32x4 (&acc)[2][2][4][2], const Unit& u, int wr, int wc, int fr, int fq) const {
        const int g = u.pn * 4 + wc;
        int mode = 0; const float* w = mqw; float sc = 1.f, nsc = 1.f;
        if (g >= 36) { mode = 2; w = mqw; nsc = qscale; }
        else if (diff) { if (g < 12) { mode = 2; w = qw; nsc = qscale; } else if (g < 24) { mode = 2; w = kw; } }
        else { if (g >= 6 && g < 12) sc = 0.125f; else if (g >= 24) mode = 1; }
        f32x4 wv[2][2];
#pragma unroll
        for (int bj = 0; bj < 2; ++bj)
#pragma unroll
            for (int n = 0; n < 2; ++n) wv[bj][n] = *(const f32x4*)(w + 32 * bj + 8 * fq + 4 * n) * nsc;
        const int lcol = u.pn * 256 + 64 * wc + 8 * fq;
        float rs[2][4];
#pragma unroll
        for (int ai = 0; ai < 2; ++ai)
#pragma unroll
            for (int m = 0; m < 4; ++m) rs[ai][m] = row_part(ss, u.pm * BM + ai * HALF + wr * 64 + m * 16 + fr, fq);
#pragma unroll
        for (int ai = 0; ai < 2; ++ai)
#pragma unroll
            for (int m = 0; m < 4; ++m) rs[ai][m] = row_finish(rs[ai][m]);
#pragma unroll
        for (int ai = 0; ai < 2; ++ai)
#pragma unroll
            for (int m = 0; m < 4; ++m) {
                const int row = u.pm * BM + ai * HALF + wr * 64 + m * 16 + fr;
                const float rstd = rs[ai][m];
                f32x4 v[2][2];
#pragma unroll
                for (int bj = 0; bj < 2; ++bj)
#pragma unroll
                    for (int n = 0; n < 2; ++n) v[bj][n] = acc[ai][bj][m][n] * rstd;
                if (mode == 2) {
                    float q = (sq4(v[0][0]) + sq4(v[0][1])) + (sq4(v[1][0]) + sq4(v[1][1]));
                    q += shx(q, 16); q += shx(q, 32);
                    const float r2 = __builtin_amdgcn_rsqf(q * (1.0f / 64.0f) + RMS_EPS);
#pragma unroll
                    for (int bj = 0; bj < 2; ++bj)
#pragma unroll
                        for (int n = 0; n < 2; ++n) v[bj][n] = v[bj][n] * r2 * wv[bj][n];
                } else if (mode == 1) {
#pragma unroll
                    for (int bj = 0; bj < 2; ++bj)
#pragma unroll
                        for (int n = 0; n < 2; ++n) v[bj][n] = silu4(v[bj][n]);
                } else {
#pragma unroll
                    for (int bj = 0; bj < 2; ++bj)
#pragma unroll
                        for (int n = 0; n < 2; ++n) v[bj][n] = v[bj][n] * sc;
                }
                bf16_t* rowp = U + (size_t)row * 2560 + lcol;
#pragma unroll
                for (int bj = 0; bj < 2; ++bj) *(u32x4*)(rowp + 32 * bj) = pack8(v[bj][0], v[bj][1]);
            }
    }
};
struct EpiMKV {
    static constexpr bool PERM = true, AFTER_DRAIN = false;
    bf16_t* MKV; const float* mkw;
    __device__ __forceinline__ void operator()(const f32x4 (&acc)[2][2][4][2], const Unit& u, int wr, int wc, int fr, int fq) const {
        const int layer = u.pn >> 1, isv = u.pn & 1;
        const float* w = mkw + layer * 64;
        f32x4 wv[2][2];
#pragma unroll
        for (int bj = 0; bj < 2; ++bj)
#pragma unroll
            for (int n = 0; n < 2; ++n) wv[bj][n] = *(const f32x4*)(w + 32 * bj + 8 * fq + 4 * n);
        const int lcol = isv * 256 + 64 * wc + 8 * fq;
#pragma unroll
        for (int ai = 0; ai < 2; ++ai)
#pragma unroll
            for (int m = 0; m < 4; ++m) {
                const int row = u.pm * BM + ai * HALF + wr * 64 + m * 16 + fr;
                f32x4 v[2][2];
#pragma unroll
                for (int bj = 0; bj < 2; ++bj)
#pragma unroll
                    for (int n = 0; n < 2; ++n) v[bj][n] = acc[ai][bj][m][n];
                if (!isv) {
                    float q = (sq4(v[0][0]) + sq4(v[0][1])) + (sq4(v[1][0]) + sq4(v[1][1]));
                    q += shx(q, 16); q += shx(q, 32);
                    const float r2 = __builtin_amdgcn_rsqf(q * (1.0f / 64.0f) + RMS_EPS);
#pragma unroll
                    for (int bj = 0; bj < 2; ++bj)
#pragma unroll
                        for (int n = 0; n < 2; ++n) v[bj][n] = v[bj][n] * r2 * wv[bj][n];
                }
                bf16_t* rowp = MKV + ((size_t)layer * 1024 + row) * 512 + lcol;
#pragma unroll
                for (int bj = 0; bj < 2; ++bj) *(u32x4*)(rowp + 32 * bj) = pack8(v[bj][0], v[bj][1]);
            }
    }
};
struct EpiRes {
    static constexpr bool PERM = true, AFTER_DRAIN = false;
    float* out; bf16_t* xb; float* ss; int last;
    __device__ __forceinline__ void operator()(const f32x4 (&acc)[2][2][4][2], const Unit& u, int wr, int wc, int fr, int fq) const {
        const int col0 = u.pn * 256 + 32 * wc + 8 * fq;
#pragma unroll
        for (int ai = 0; ai < 2; ++ai) {
            u32x4 bs[4][2];
#pragma unroll
            for (int m = 0; m < 4; ++m)
#pragma unroll
                for (int bj = 0; bj < 2; ++bj) bs[m][bj] = *(const u32x4*)(xb + (size_t)(u.pm * BM + ai * HALF + wr * 64 + m * 16 + fr) * 1024 + col0 + 128 * bj);
#pragma unroll
            for (int m = 0; m < 4; ++m) {
                const int row = u.pm * BM + ai * HALF + wr * 64 + m * 16 + fr;
                float q = 0.f;
#pragma unroll
                for (int bj = 0; bj < 2; ++bj) {
                    const size_t off = (size_t)row * 1024 + col0 + 128 * bj; const u32x4 w = bs[m][bj];
                    const f32x4 b0 = (f32x4){__builtin_bit_cast(float, w.x << 16), __builtin_bit_cast(float, w.x & 0xffff0000u), __builtin_bit_cast(float, w.y << 16), __builtin_bit_cast(float, w.y & 0xffff0000u)};
                    const f32x4 b1 = (f32x4){__builtin_bit_cast(float, w.z << 16), __builtin_bit_cast(float, w.z & 0xffff0000u), __builtin_bit_cast(float, w.w << 16), __builtin_bit_cast(float, w.w & 0xffff0000u)};
                    const f32x4 v0 = acc[ai][bj][m][0] + b0, v1 = acc[ai][bj][m][1] + b1;
                    if (last) { __builtin_nontemporal_store(v0, (f32x4*)(out + off)); __builtin_nontemporal_store(v1, (f32x4*)(out + off + 4)); }
                    else { q += sq4(v0) + sq4(v1); *(u32x4*)(xb + off) = pack8(v0, v1); }
                }
                if (!last) { q += shx(q, 16); q += shx(q, 32); if (fq == 0) ss[(size_t)row * 16 + u.pn * 4 + wc] = q; }
            }
        }
    }
};
struct EpiSwi {
    static constexpr bool PERM = true, AFTER_DRAIN = false;
    bf16_t* ACT; const float* ss;
    __device__ __forceinline__ void operator()(const f32x4 (&acc)[2][2][4][2], const Unit& u, int wr, int wc, int fr, int fq) const {
        const int col0 = u.pn * 128 + 32 * wc + 8 * fq;
        float rs[2][4];
#pragma unroll
        for (int ai = 0; ai < 2; ++ai)
#pragma unroll
            for (int m = 0; m < 4; ++m) rs[ai][m] = row_part(ss, u.pm * BM + ai * HALF + wr * 64 + m * 16 + fr, fq);
#pragma unroll
        for (int ai = 0; ai < 2; ++ai)
#pragma unroll
            for (int m = 0; m < 4; ++m) rs[ai][m] = row_finish(rs[ai][m]);
#pragma unroll
        for (int ai = 0; ai < 2; ++ai)
#pragma unroll
            for (int m = 0; m < 4; ++m) {
                const int row = u.pm * BM + ai * HALF + wr * 64 + m * 16 + fr;
                const float rstd = rs[ai][m];
                const f32x4 a0 = silu4(acc[ai][0][m][0] * rstd) * (acc[ai][1][m][0] * rstd);
                const f32x4 a1 = silu4(acc[ai][0][m][1] * rstd) * (acc[ai][1][m][1] * rstd);
                *(u32x4*)(ACT + (size_t)row * 2816 + col0) = pack8(a0, a1);
            }
    }
};
struct TailOrder {
    int nM, nN, first, c;
    __device__ bool next(int i, Unit& u) const { if (i > 0) return false; const int t = c - first; if (t < 0 || t >= nM * nN) return false; u.pm = t % nM; u.pn = t / nM; return true; }
    __device__ __forceinline__ void a_ready(const Unit&) const {}
    __device__ __forceinline__ void done(const Unit&) const {}
};
template <class Epi, class Sched, bool ALIGN_EPI = false, bool SP2 = false>
__device__ __forceinline__ void gemm_phase(PG8_LAS unsigned char* lds, const Gemm g, const Sched& S, const Epi& E, int tid_in) {
    int tid_ = tid_in; asm volatile("" : "+v"(tid_));
    const int tid = tid_, wid = __builtin_amdgcn_readfirstlane(tid >> 6), lane = tid & 63, wr = wid >> 2, wc = wid & 3, fr = lane & 15, fq = lane >> 4;
    const int K = g.K, nt = K / BK;
    unsigned voffA[2], voffB[2];
#pragma unroll
    for (int i = 0; i < 2; ++i) { int R, C; stage_rc(tid * 16 + i * 8192, R, C); const int Rb = Epi::PERM ? ((R & ~31) + perm32(R & 31)) : R;
        voffA[i] = (unsigned)(R * K + C) * 2u; voffB[i] = (unsigned)(Rb * K + C) * 2u; }
    const size_t kstep = (size_t)(BK * 2);
    const size_t hstep = (size_t)HALF * K * 2;
    const size_t tstep = 2 * hstep;
    const unsigned ldsw = (unsigned)wid * 1024u;
    const int aoff = lds_byte(wr * 64 + fr, fq * 8), boff = lds_byte(wc * 32 + fr, fq * 8);
#define PG8_SA(b, h) (((b) * 2 + (h)) * HTB)
#define PG8_SB(b, h) ((4 + (b) * 2 + (h)) * HTB)
#define PG8_STAGE(bufoff, gbase, voff) do { _Pragma("unroll") for (int _i = 0; _i < 2; ++_i) \
        __builtin_amdgcn_global_load_lds((const unsigned*)((const char*)(gbase) + (voff)[_i]), (PG8_LAS unsigned*)(lds + (bufoff) + ldsw + _i * 8192), 16, 0, 0); } while (0)
#define PG8_LDA(dst, b, h) do { _Pragma("unroll") for (int m = 0; m < 4; ++m) _Pragma("unroll") for (int k = 0; k < 2; ++k) dst[m][k] = *(const PG8_LAS bf16x8*)(lds + PG8_SA(b, h) + aoff + m * 2048 + k * 1024); } while (0)
#define PG8_LDB(dst, b, h) do { _Pragma("unroll") for (int n = 0; n < 2; ++n) _Pragma("unroll") for (int k = 0; k < 2; ++k) dst[n][k] = *(const PG8_LAS bf16x8*)(lds + PG8_SB(b, h) + boff + n * 2048 + k * 1024); } while (0)
#define PG8_MMA(ai, bj, At, Bt) do { __builtin_amdgcn_s_setprio(1); _Pragma("unroll") for (int m = 0; m < 4; ++m) _Pragma("unroll") for (int n = 0; n < 2; ++n) _Pragma("unroll") for (int k = 0; k < 2; ++k) \
        acc[ai][bj][m][n] = __builtin_amdgcn_mfma_f32_16x16x32_bf16(Bt[n][k], At[m][k], acc[ai][bj][m][n], 0, 0, 0); __builtin_amdgcn_s_setprio(0); } while (0)
#define PG8_WAIT_V(n) asm volatile("s_waitcnt vmcnt(" #n ")" ::: "memory")
#define PG8_WAIT_L(n) asm volatile("s_waitcnt lgkmcnt(" #n ")" ::: "memory")
#define PG8_BAR __builtin_amdgcn_s_barrier()
#define PG8_SCHED __builtin_amdgcn_sched_barrier(0)
    Unit cur, nxt; int ui = 0;
    if (!S.next(0, cur)) return;
    f32x4 acc[2][2][4][2];
#pragma unroll
    for (int a = 0; a < 2; ++a)
#pragma unroll
        for (int b = 0; b < 2; ++b)
#pragma unroll
            for (int m = 0; m < 4; ++m)
#pragma unroll
                for (int n = 0; n < 2; ++n) acc[a][b][m][n] = (f32x4){0.f, 0.f, 0.f, 0.f};
    bf16x8 At[4][2], B0[2][2], B1[2][2];
    const char* cA = (const char*)g.A + (size_t)cur.pm * tstep; const char* cB = (const char*)g.Bt + (size_t)cur.pn * tstep;
    S.a_ready(cur);
    if constexpr (SP2) {
        PG8_STAGE(PG8_SB(0, 0), cB, voffB); PG8_STAGE(PG8_SB(0, 1), cB + hstep, voffB); PG8_STAGE(PG8_SA(0, 0), cA, voffA); PG8_STAGE(PG8_SA(0, 1), cA + hstep, voffA);
        if (wr == 1) PG8_BAR;
        PG8_WAIT_V(2); PG8_BAR;
        PG8_STAGE(PG8_SB(1, 0), cB + kstep, voffB); PG8_STAGE(PG8_SA(1, 0), cA + kstep, voffA); PG8_STAGE(PG8_SB(1, 1), cB + hstep + kstep, voffB);
        PG8_WAIT_V(6); PG8_BAR;
    } else {
        PG8_STAGE(PG8_SB(0, 0), cB, voffB); PG8_STAGE(PG8_SA(0, 0), cA, voffA); PG8_STAGE(PG8_SB(0, 1), cB + hstep, voffB); PG8_STAGE(PG8_SA(0, 1), cA + hstep, voffA);
        if (wr == 1) PG8_BAR;
        PG8_WAIT_V(4); PG8_BAR;
        PG8_STAGE(PG8_SB(1, 0), cB + kstep, voffB); PG8_STAGE(PG8_SA(1, 0), cA + kstep, voffA); PG8_STAGE(PG8_SB(1, 1), cB + hstep + kstep, voffB);
        PG8_WAIT_V(6); PG8_BAR;
    }
    for (;;) {
        const bool has_next = S.next(ui + 1, nxt);
        const char* nA = has_next ? (const char*)g.A + (size_t)nxt.pm * tstep : cA; const char* nB = has_next ? (const char*)g.Bt + (size_t)nxt.pn * tstep : cB;
        for (int t = 0; t < nt; t += 2) {
            const bool last = (t == nt - 2);
            const char* a1 = cA + (size_t)(t + 1) * kstep;
            const char* a2 = last ? nA : cA + (size_t)(t + 2) * kstep; const char* b2 = last ? nB : cB + (size_t)(t + 2) * kstep;
            const char* a3 = a2 + kstep; const char* b3 = b2 + kstep;
            if (last && has_next) S.a_ready(nxt);
            if constexpr (SP2) {
            PG8_LDB(B0, 0, 0); PG8_LDB(B1, 0, 1); PG8_SCHED; PG8_LDA(At, 0, 0); PG8_STAGE(PG8_SA(1, 1), a1 + hstep, voffA);
            PG8_WAIT_V(8); PG8_WAIT_L(0); PG8_BAR; PG8_MMA(0, 0, At, B0); PG8_MMA(0, 1, At, B1); PG8_BAR; PG8_SCHED;
            PG8_LDA(At, 0, 1); PG8_STAGE(PG8_SB(0, 0), b2, voffB); PG8_STAGE(PG8_SB(0, 1), b2 + hstep, voffB); PG8_STAGE(PG8_SA(0, 0), a2, voffA);
            PG8_WAIT_V(8); PG8_WAIT_L(0); PG8_BAR; PG8_MMA(1, 0, At, B0); PG8_MMA(1, 1, At, B1); PG8_BAR; PG8_SCHED;
            PG8_LDB(B0, 1, 0); PG8_LDB(B1, 1, 1); PG8_SCHED; PG8_LDA(At, 1, 0); PG8_STAGE(PG8_SA(0, 1), a2 + hstep, voffA);
            PG8_WAIT_V(8); PG8_WAIT_L(0); PG8_BAR; PG8_MMA(0, 0, At, B0); PG8_MMA(0, 1, At, B1); PG8_BAR; PG8_SCHED;
            PG8_LDA(At, 1, 1); PG8_STAGE(PG8_SB(1, 0), b3, voffB); PG8_STAGE(PG8_SB(1, 1), b3 + hstep, voffB); PG8_STAGE(PG8_SA(1, 0), a3, voffA);
            PG8_WAIT_V(8); PG8_WAIT_L(0); PG8_BAR; PG8_MMA(1, 0, At, B0); PG8_MMA(1, 1, At, B1); PG8_BAR; PG8_SCHED;
            } else {
            PG8_LDB(B0, 0, 0); PG8_SCHED; PG8_LDA(At, 0, 0); PG8_STAGE(PG8_SA(1, 1), a1 + hstep, voffA);
            PG8_WAIT_L(8); PG8_BAR; PG8_WAIT_L(0); PG8_MMA(0, 0, At, B0); PG8_BAR; PG8_SCHED;
            PG8_LDB(B1, 0, 1); PG8_STAGE(PG8_SB(0, 0), b2, voffB);
            PG8_BAR; PG8_WAIT_L(0); PG8_MMA(0, 1, At, B1); PG8_BAR;
            PG8_LDA(At, 0, 1); PG8_STAGE(PG8_SA(0, 0), a2, voffA);
            PG8_BAR; PG8_WAIT_L(0); PG8_MMA(1, 0, At, B0); PG8_BAR; PG8_SCHED;
            PG8_STAGE(PG8_SB(0, 1), b2 + hstep, voffB);
            PG8_WAIT_V(6); PG8_BAR; PG8_MMA(1, 1, At, B1); PG8_BAR;
            PG8_LDB(B0, 1, 0); PG8_SCHED; PG8_LDA(At, 1, 0); PG8_STAGE(PG8_SA(0, 1), a2 + hstep, voffA);
            PG8_WAIT_L(8); PG8_BAR; PG8_WAIT_L(0); PG8_MMA(0, 0, At, B0); PG8_BAR; PG8_SCHED;
            PG8_LDB(B1, 1, 1); PG8_STAGE(PG8_SB(1, 0), b3, voffB);
            PG8_BAR; PG8_WAIT_L(0); PG8_MMA(0, 1, At, B1); PG8_BAR;
            PG8_LDA(At, 1, 1); PG8_STAGE(PG8_SA(1, 0), a3, voffA);
            PG8_BAR; PG8_WAIT_L(0); PG8_MMA(1, 0, At, B0); PG8_BAR; PG8_SCHED;
            PG8_STAGE(PG8_SB(1, 1), b3 + hstep, voffB);
            PG8_WAIT_V(6); PG8_BAR; PG8_MMA(1, 1, At, B1); PG8_BAR;
            }
        }
        if constexpr (ALIGN_EPI) { if (wr == 0) PG8_BAR; }
        if constexpr (!Epi::AFTER_DRAIN) { E(acc, cur, wr, wc, fr, fq); S.done(cur); }
        if (!has_next) break;
#pragma unroll
        for (int a = 0; a < 2; ++a)
#pragma unroll
            for (int b = 0; b < 2; ++b)
#pragma unroll
                for (int m = 0; m < 4; ++m)
#pragma unroll
                    for (int n = 0; n < 2; ++n) acc[a][b][m][n] = (f32x4){0.f, 0.f, 0.f, 0.f};
        cur = nxt; cA = nA; cB = nB; ++ui;
        if constexpr (ALIGN_EPI) { if (wr == 1) PG8_BAR; }
    }
    PG8_WAIT_V(0);
    if constexpr (!ALIGN_EPI) { if (wr == 0) PG8_BAR; }
    PG8_BAR;
    if constexpr (Epi::AFTER_DRAIN) { E.fused(acc, cur, wr, wc, fr, fq, lds, wid, lane); S.done(cur); }
#undef PG8_SA
#undef PG8_SB
#undef PG8_STAGE
#undef PG8_LDA
#undef PG8_LDB
#undef PG8_MMA
#undef PG8_WAIT_V
#undef PG8_WAIT_L
#undef PG8_BAR
#undef PG8_SCHED
}
}

namespace cg = cooperative_groups;
#define LAS __attribute__((address_space(3)))
typedef unsigned short bf16;
typedef unsigned v4u __attribute__((ext_vector_type(4)));
typedef unsigned v2u __attribute__((ext_vector_type(2)));
typedef float f32x4 __attribute__((ext_vector_type(4)));

constexpr int NWAVES = 8, NTHR = 512;
constexpr int BATCH = 4, SEQ = 4096, D = 1024, M = BATCH * SEQ, DEPTH = 4;
constexpr int INW = 2560, FFN = 2816, GU = 2 * FFN, MEMR = BATCH * 256, MAINW = 768;
constexpr float EPS = 1e-6f;
constexpr size_t MiB = 1u << 20;
constexpr size_t WS_CTL = 0;
constexpr size_t WS_WIN = 1 * MiB;
constexpr size_t WS_WOUT = 21 * MiB;
constexpr size_t WS_WGU = 29 * MiB;
constexpr size_t WS_WDN = 73 * MiB;
constexpr size_t WS_WMKV = 95 * MiB;
constexpr size_t WS_MEMN = 99 * MiB;
constexpr size_t WS_MKV = 101 * MiB;
constexpr size_t WS_XB = 105 * MiB;
constexpr size_t WS_SS = 137 * MiB;
constexpr size_t WS_U = 138 * MiB;
constexpr size_t WS_O = 218 * MiB;
constexpr size_t WS_ACT = WS_U;
constexpr size_t WS_KV = 250 * MiB;
constexpr size_t WS_END = 298 * MiB;
constexpr int LDS_BYTES = 147456;

__device__ __forceinline__ unsigned f2bf(float f) { unsigned u = __builtin_bit_cast(unsigned, f); return (u + 0x7fffu + ((u >> 16) & 1u)) >> 16; }
__device__ __forceinline__ unsigned pk2(float lo, float hi) { return f2bf(lo) | (f2bf(hi) << 16); }
__device__ __forceinline__ float bflo(unsigned w) { return __builtin_bit_cast(float, w << 16); }
__device__ __forceinline__ float bfhi(unsigned w) { return __builtin_bit_cast(float, w & 0xffff0000u); }
__device__ __forceinline__ float wave_sum(float v) {
#pragma unroll
    for (int o = 1; o < 64; o <<= 1) v += shx(v, o);
    return v;
}

struct Args {
    const float* in[20]; float* out; unsigned char* ws;
};

__device__ __forceinline__ int map_row(int n, int mode) {
    if (mode == 1) return (n & ~255) + 128 * ((n >> 5) & 1) + 32 * ((n >> 6) & 3) + (n & 31);
    if (mode == 2) { if (n < FFN) return 256 * (n / 128) + (n % 128); const int j = n - FFN; return 256 * (j / 128) + 128 + (j % 128); }
    return n;
}
__device__ __forceinline__ void transpose_item(const float* __restrict__ W, int K, int N, bf16* __restrict__ WT, const float* __restrict__ ksc, int mode, int row_off, int item, int lane) {
    const int nblk = N / 64, kb = item / nblk, nb = item % nblk, k0 = 64 * kb, n = 64 * nb + lane;
    const float* src = W + (size_t)k0 * N + n;
    float v[64];
#pragma unroll
    for (int i = 0; i < 64; ++i) v[i] = __builtin_nontemporal_load(src + (size_t)i * N);
    if (ksc) {
#pragma unroll
        for (int i = 0; i < 64; ++i) v[i] *= ksc[k0 + i];
    }
    bf16* dst = WT + (size_t)(row_off + map_row(n, mode)) * K + k0;
#pragma unroll
    for (int j = 0; j < 8; ++j) { v4u o; o.x = pk2(v[8 * j], v[8 * j + 1]); o.y = pk2(v[8 * j + 2], v[8 * j + 3]); o.z = pk2(v[8 * j + 4], v[8 * j + 5]); o.w = pk2(v[8 * j + 6], v[8 * j + 7]);
        *(v4u*)(dst + 8 * j) = o; }
}
__device__ __forceinline__ float row_to_bf16(const float* xrow, bf16* orow, const float* w, bool norm, int lane) {
    const f32x4* xr = (const f32x4*)xrow + lane;
    f32x4 v[4]; float s = 0.f;
#pragma unroll
    for (int j = 0; j < 4; ++j) { v[j] = __builtin_nontemporal_load(xr + 64 * j); s += (v[j].x * v[j].x + v[j].y * v[j].y) + (v[j].z * v[j].z + v[j].w * v[j].w); }
    s = wave_sum(s);
    if (norm) { const float r = 1.0f / sqrtf(s * (1.0f / 1024.0f) + EPS);
#pragma unroll
        for (int j = 0; j < 4; ++j) { const f32x4 wv = ((const f32x4*)w)[lane + 64 * j]; v[j] = v[j] * r * wv; } }
    unsigned long long* o8 = (unsigned long long*)orow + lane;
#pragma unroll
    for (int j = 0; j < 4; ++j) o8[64 * j] = (unsigned long long)pk2(v[j].x, v[j].y) | ((unsigned long long)pk2(v[j].z, v[j].w) << 32);
    return s;
}

#define XB_TMO      128
#define XB_XCNT(j)  (256  + 64 * (j))
#define XB_XSUB(j)  (1280 + 64 * (j))
#define XB_XGEN(j)  (2304 + 64 * (j))
#define XB_TOP      3328
#define XB_TOPGEN   3392
#define XCD_BAR_WORDS 3456
#define XB_SPIN_CAP (1u << 18)

__device__ __forceinline__ unsigned xb_ld(unsigned* p)              { return __hip_atomic_load(p, __ATOMIC_RELAXED, __HIP_MEMORY_SCOPE_AGENT); }
__device__ __forceinline__ unsigned xb_add(unsigned* p, unsigned v) { return __hip_atomic_fetch_add(p, v, __ATOMIC_RELAXED, __HIP_MEMORY_SCOPE_AGENT); }
__device__ __forceinline__ unsigned xb_xcc_id() { return (unsigned)__builtin_amdgcn_s_getreg((3 << 11) | 20) & 0xFu; }
#define XB_SPIN(cond, bar) do { unsigned _sp = 0; while (cond) { __builtin_amdgcn_s_sleep(1); \
    if ((++_sp & 255u) == 0u) { if (xb_ld(&(bar)[XB_TMO])) break; if (_sp > XB_SPIN_CAP) { atomicAdd(&(bar)[XB_TMO], 1u); break; } } } } while (0)

struct XcdBarrier {
    unsigned* bar; unsigned x; bool leader;
    volatile LAS unsigned* st;
};

__device__ __forceinline__ XcdBarrier xcd_barrier_post(unsigned* bar, volatile LAS unsigned* st, bool leader) {
    XcdBarrier b; b.bar = bar; b.x = xb_xcc_id(); b.st = st; b.leader = leader;
    if (leader) (void)xb_add(&bar[XB_XCNT(b.x)], 1u);
    return b;
}
__device__ __forceinline__ void xcd_barrier_complete(unsigned* bar, unsigned x, unsigned& nloc, unsigned& nx) {
    const unsigned G = gridDim.x * gridDim.y * gridDim.z;
    unsigned sum, cnt, mine, sp = 0u;
    for (;;) {
        sum = 0u; cnt = 0u; mine = 0u;
#pragma unroll
        for (unsigned j = 0; j < 16; ++j) { const unsigned c = xb_ld(&bar[XB_XCNT(j)]); sum += c; cnt += (c > 0u) ? 1u : 0u; mine = (j == x) ? c : mine; }
        if (sum == G) break;
        __builtin_amdgcn_s_sleep(1);
        if ((++sp & 255u) == 0u) { if (xb_ld(&bar[XB_TMO])) break; if (sp > XB_SPIN_CAP) { atomicAdd(&bar[XB_TMO], 1u); break; } }
    }
    nloc = mine > 0u ? mine : 1u; nx = cnt > 0u ? cnt : 1u;
}

__device__ __forceinline__ void xcd_barrier(const XcdBarrier& b) {
    asm volatile("s_waitcnt vmcnt(0)" ::: "memory");
    __syncthreads();
    if (b.leader) {
        unsigned* bar = b.bar;
        __builtin_amdgcn_s_waitcnt(0);
        unsigned nloc = b.st[0], nx = b.st[1];
        if (nloc == 0u) { xcd_barrier_complete(bar, b.x, nloc, nx); b.st[0] = nloc; b.st[1] = nx; }
        const unsigned old = xb_add(&bar[XB_XSUB(b.x)], 1u);
        const unsigned gen = old / nloc;
        if (old + 1u == (gen + 1u) * nloc) {
            __builtin_amdgcn_fence(__ATOMIC_RELEASE, "agent");
            asm volatile("s_waitcnt vmcnt(0)" ::: "memory");
            const unsigned og = xb_add(&bar[XB_TOP], 1u);
            const unsigned tg = og / nx;
            if (og + 1u == (tg + 1u) * nx) xb_add(&bar[XB_TOPGEN], 1u);
            else XB_SPIN(xb_ld(&bar[XB_TOPGEN]) == tg, bar);
            __builtin_amdgcn_fence(__ATOMIC_ACQUIRE, "agent");
            xb_add(&bar[XB_XGEN(b.x)], 1u);
            asm volatile("s_waitcnt vmcnt(0)" ::: "memory");
        } else {
            XB_SPIN(xb_ld(&bar[XB_XGEN(b.x)]) == gen, bar);
            __builtin_amdgcn_fence(__ATOMIC_ACQUIRE, "agent");
            asm volatile("s_waitcnt vmcnt(0)" ::: "memory");
        }
    }
    __syncthreads();
}


namespace att {
typedef short bf16x8 __attribute__((ext_vector_type(8)));
typedef short s16x4 __attribute__((ext_vector_type(4)));
typedef float f32x16 __attribute__((ext_vector_type(16)));
typedef float f32x2_t __attribute__((ext_vector_type(2)));
typedef __bf16 bf16x2_t __attribute__((ext_vector_type(2)));
#define ALDS __attribute__((address_space(3)))
typedef ALDS unsigned char* ldsp;
constexpr float LOG2E = 1.4426950408889634f;

__device__ __forceinline__ unsigned off_b(unsigned row, unsigned ch) { return 256u * row + 16u * (ch ^ (((row & 3u) << 2) | ((row >> 2) & 3u))); }
__device__ __forceinline__ unsigned cvtpk(float lo, float hi) { f32x2_t v = {lo, hi}; bf16x2_t b = __builtin_convertvector(v, bf16x2_t); return __builtin_bit_cast(unsigned, b); }
__device__ __forceinline__ s16x4 vtr(ldsp p) { typedef short v4i16_t __attribute__((ext_vector_type(4))); return __builtin_bit_cast(s16x4, __builtin_amdgcn_ds_read_tr16_b64_v4i16((ALDS v4i16_t*)p)); }
#define TR_ISSUE(dst, addr, OFF) dst = vtr((ldsp)(size_t)((addr) + (unsigned)(OFF)))
template <int N> __device__ __forceinline__ void tr_wait(s16x4 (&lo)[N], s16x4 (&hi)[N]) {}
__device__ __forceinline__ void dma16(const void* g, ldsp l) {
    unsigned keep; const unsigned d = (unsigned)__builtin_amdgcn_readfirstlane((int)(unsigned)(size_t)l);
    asm volatile("s_mov_b32 %0, m0\n\ts_mov_b32 m0, %2\n\ts_nop 0\n\tglobal_load_lds_dwordx4 %1, off\n\ts_mov_b32 m0, %0" : "=&s"(keep) : "v"(g), "s"(d) : "memory");
}
__device__ __forceinline__ void wait_all_barrier() { asm volatile("s_waitcnt vmcnt(0) lgkmcnt(0)\n\ts_barrier" ::: "memory"); }
__device__ __forceinline__ float wave_max(float v) {
#pragma unroll
    for (int o = 1; o < 64; o <<= 1) v = fmaxf(v, shx(v, o));
    return v;
}
__device__ __forceinline__ bf16x8 pack8s(const f32x16& s, int b) {
    typedef unsigned u4 __attribute__((ext_vector_type(4)));
    u4 w; w.x = cvtpk(s[b], s[b + 1]); w.y = cvtpk(s[b + 2], s[b + 3]); w.z = cvtpk(s[b + 4], s[b + 5]); w.w = cvtpk(s[b + 6], s[b + 7]);
    return __builtin_bit_cast(bf16x8, w);
}
struct LaneAddr { unsigned kb[4]; unsigned vb[8]; };
template <int NET>
__device__ __forceinline__ void lane_addr(LaneAddr& A, int kch0, int vch0, int lane) {
    const unsigned r = lane & 31, hh = lane >> 5, blk = (lane >> 4) & 1, qq = (lane & 15) >> 2, p = lane & 3;
    const unsigned lk = hh ^ (((r & 3u) << 2) | ((r >> 2) & 3u));
#pragma unroll
    for (int ks = 0; ks < 4; ++ks) A.kb[ks] = 256u * r + 16u * (((unsigned)kch0 + 2u * ks) ^ lk);
    const unsigned lv = ((2u * blk) | (p >> 1)) ^ ((qq << 2) | hh);
#pragma unroll
    for (int et = 0; et < NET; ++et)
#pragma unroll
        for (int t = 0; t < 2; ++t) A.vb[2 * et + t] = 256u * (4u * hh + qq) + 8u * (p & 1u) + 16u * ((((unsigned)vch0 + 4u * et) ^ (2u * t)) ^ lv);
}
template <int NET, bool BIAS>
__device__ __forceinline__ void attn_tile(f32x16 (&o)[NET], float& lsum, const bf16x8 (&qf)[4], const LaneAddr& A, unsigned kimg, unsigned vimg, float nslope2, float negM0, float dt) {
    bf16x8 kf[2][4];
#pragma unroll
    for (int ks = 0; ks < 4; ++ks) { const unsigned ka = A.kb[ks] + kimg;
        kf[0][ks] = *(const ALDS bf16x8*)(size_t)(ka); kf[1][ks] = *(const ALDS bf16x8*)(size_t)(ka + 8192u); }
    f32x16 s[2];
#pragma unroll
    for (int sub = 0; sub < 2; ++sub) {
        if (BIAS) { const float d0 = dt - 32.0f * (float)sub;
#pragma unroll
            for (int i = 0; i < 16; ++i) s[sub][i] = fmaf(nslope2, fabsf(d0 - (float)((i & 3) + 8 * (i >> 2))), negM0);
        } else {
#pragma unroll
            for (int i = 0; i < 16; ++i) s[sub][i] = negM0;
        }
    }
#pragma unroll
    for (int ks = 0; ks < 4; ++ks) { s[0] = __builtin_amdgcn_mfma_f32_32x32x16_bf16(kf[0][ks], qf[ks], s[0], 0, 0, 0); s[1] = __builtin_amdgcn_mfma_f32_32x32x16_bf16(kf[1][ks], qf[ks], s[1], 0, 0, 0); }
    unsigned va[NET][2];
#pragma unroll
    for (int et = 0; et < NET; ++et) { va[et][0] = A.vb[2 * et] + vimg; va[et][1] = A.vb[2 * et + 1] + vimg; }
    s16x4 vlo[2][NET], vhi[2][NET];
#pragma unroll
    for (int et = 0; et < NET; ++et) { TR_ISSUE(vlo[0][et], va[et][0], 0); TR_ISSUE(vhi[0][et], va[et][1], 2048); }
    bf16x8 pa[2][2];
#pragma unroll
    for (int sub = 0; sub < 2; ++sub) {
#pragma unroll
        for (int i = 0; i < 16; ++i) { s[sub][i] = __builtin_amdgcn_exp2f(s[sub][i]); lsum += s[sub][i]; }
        pa[sub][0] = pack8s(s[sub], 0); pa[sub][1] = pack8s(s[sub], 8);
    }
    tr_wait<NET>(vlo[0], vhi[0]);
    __builtin_amdgcn_sched_barrier(0);
#pragma unroll
    for (int step = 0; step < 4; ++step) {
        const int cur = step & 1, nxt = cur ^ 1;
        if (step < 3) {
#pragma unroll
            for (int et = 0; et < NET; ++et) { TR_ISSUE(vlo[nxt][et], va[et][0], 256 * (32 * ((step + 1) >> 1) + 16 * ((step + 1) & 1))); TR_ISSUE(vhi[nxt][et], va[et][1], 256 * (32 * ((step + 1) >> 1) + 16 * ((step + 1) & 1)) + 2048); } }
#pragma unroll
        for (int et = 0; et < NET; ++et) {
            const bf16x8 vf = (bf16x8){vlo[cur][et][0], vlo[cur][et][1], vlo[cur][et][2], vlo[cur][et][3], vhi[cur][et][0], vhi[cur][et][1], vhi[cur][et][2], vhi[cur][et][3]};
            o[et] = __builtin_amdgcn_mfma_f32_32x32x16_bf16(vf, pa[step >> 1][step & 1], o[et], 0, 0, 0);
        }
        if (step < 3) tr_wait<NET>(vlo[nxt], vhi[nxt]);
        __builtin_amdgcn_sched_barrier(0);
    }
}

#define MF32(acc, a, b) acc = __builtin_amdgcn_mfma_f32_32x32x16_bf16(a, b, acc, 0, 0, 0)
#define SBAR0() __builtin_amdgcn_sched_barrier(0)
#define VFRAG(buf, et) (bf16x8){vlo[buf][et][0], vlo[buf][et][1], vlo[buf][et][2], vlo[buf][et][3], vhi[buf][et][0], vhi[buf][et][1], vhi[buf][et][2], vhi[buf][et][3]}
__device__ __forceinline__ void bias_tile(f32x16 (&s)[2], float nslope2, float negM0, float dt) {
#pragma unroll
    for (int sub = 0; sub < 2; ++sub) { const float d0 = dt - 32.0f * (float)sub;
#pragma unroll
        for (int i = 0; i < 16; ++i) s[sub][i] = fmaf(nslope2, fabsf(d0 - (float)((i & 3) + 8 * (i >> 2))), negM0); }
}
__device__ __forceinline__ void bias_tile_past(f32x16 (&s)[2], float nslope2, float negM0, float dt) {
    const float slope2 = -nslope2;
#pragma unroll
    for (int sub = 0; sub < 2; ++sub) { const float cb = fmaf(nslope2, dt - 32.0f * (float)sub, negM0);
#pragma unroll
        for (int i = 0; i < 16; ++i) asm("v_fmamk_f32 %0, %1, %3, %2" : "=v"(s[sub][i]) : "v"(slope2), "v"(cb), "i"(__builtin_bit_cast(int, (float)((i & 3) + 8 * (i >> 2))))); }
}
template <bool PAST, bool PAST1 = PAST>
__device__ __forceinline__ void attn_pair(f32x16 (&o)[4], float& lsum, const bf16x8 (&qf)[4], const LaneAddr& A, unsigned k0, unsigned v0, unsigned k1, unsigned v1, float nslope2, float negM0, float dt0, float dt1) {
    bf16x8 kf[2][4];
    f32x16 s0[2], s1[2];
    bf16x8 pa0[2][2], pa1[2][2];
    s16x4 vlo[2][4], vhi[2][4];
#pragma unroll
    for (int ks = 0; ks < 4; ++ks) { const unsigned ka = A.kb[ks] + k0; kf[0][ks] = *(const ALDS bf16x8*)(size_t)(ka); kf[1][ks] = *(const ALDS bf16x8*)(size_t)(ka + 8192u); }
    if (PAST) bias_tile_past(s0, nslope2, negM0, dt0); else bias_tile(s0, nslope2, negM0, dt0);
#pragma unroll
    for (int ks = 0; ks < 4; ++ks) { MF32(s0[0], kf[0][ks], qf[ks]); MF32(s0[1], kf[1][ks], qf[ks]); }
    SBAR0();
    if (PAST1) bias_tile_past(s1, nslope2, negM0, dt1); else bias_tile(s1, nslope2, negM0, dt1);
    unsigned va0[4][2];
#pragma unroll
    for (int et = 0; et < 4; ++et) { va0[et][0] = A.vb[2 * et] + v0; va0[et][1] = A.vb[2 * et + 1] + v0; }
    bf16x8 k2[2][2];
    { const unsigned ka = A.kb[0] + k1; k2[0][0] = *(const ALDS bf16x8*)(size_t)(ka); k2[0][1] = *(const ALDS bf16x8*)(size_t)(ka + 8192u); }
    SBAR0();
#pragma unroll
    for (int g = 0; g < 8; ++g) {
        const int ks = g >> 1, sub = g & 1;
        if (sub == 0 && ks < 3) { const unsigned ka = A.kb[ks + 1] + k1; k2[(ks + 1) & 1][0] = *(const ALDS bf16x8*)(size_t)(ka); k2[(ks + 1) & 1][1] = *(const ALDS bf16x8*)(size_t)(ka + 8192u); }
        MF32(s1[sub], k2[ks & 1][sub], qf[ks]);
#pragma unroll
        for (int k = 0; k < 4; ++k) { const int idx = 4 * g + k; s0[idx >> 4][idx & 15] = __builtin_amdgcn_exp2f(s0[idx >> 4][idx & 15]); lsum += s0[idx >> 4][idx & 15]; }
        if (g & 1) pa0[g >> 2][(g >> 1) & 1] = pack8s(s0[g >> 2], 8 * ((g >> 1) & 1));
        if (g == 6) {
#pragma unroll
            for (int et = 0; et < 4; ++et) { TR_ISSUE(vlo[0][et], va0[et][0], 0); TR_ISSUE(vhi[0][et], va0[et][1], 2048); } }
        SBAR0();
    }
    tr_wait<4>(vlo[0], vhi[0]);
    SBAR0();
    unsigned va1[4][2];
#pragma unroll
    for (int g = 0; g < 16; ++g) {
        const int step = g >> 2, et = g & 3, cur = step & 1, nxt = cur ^ 1;
        if (et == 0) {
            if (step < 3) {
#pragma unroll
                for (int e2 = 0; e2 < 4; ++e2) { TR_ISSUE(vlo[nxt][e2], va0[e2][0], 256 * (32 * ((step + 1) >> 1) + 16 * ((step + 1) & 1))); TR_ISSUE(vhi[nxt][e2], va0[e2][1], 256 * (32 * ((step + 1) >> 1) + 16 * ((step + 1) & 1)) + 2048); }
            } else {
#pragma unroll
                for (int e2 = 0; e2 < 4; ++e2) { va1[e2][0] = A.vb[2 * e2] + v1; va1[e2][1] = A.vb[2 * e2 + 1] + v1; TR_ISSUE(vlo[nxt][e2], va1[e2][0], 0); TR_ISSUE(vhi[nxt][e2], va1[e2][1], 2048); }
            }
        }
        MF32(o[et], VFRAG(cur, et), pa0[step >> 1][step & 1]);
#pragma unroll
        for (int k = 0; k < 2; ++k) { const int idx = 2 * g + k; s1[idx >> 4][idx & 15] = __builtin_amdgcn_exp2f(s1[idx >> 4][idx & 15]); lsum += s1[idx >> 4][idx & 15]; }
        if (et == 3) { pa1[step >> 1][step & 1] = pack8s(s1[step >> 1], 8 * (step & 1)); tr_wait<4>(vlo[nxt], vhi[nxt]); }
        SBAR0();
    }
    if (PROBE == 7) { float dmy = negM0;
#pragma unroll
        for (int i = 0; i < 64; ++i) asm volatile("v_exp_f32 %0, %0" : "+v"(dmy)); }
    if (PROBE == 8) { s16x4 dm;
#pragma unroll
        for (int i = 0; i < 64; ++i) asm volatile("ds_read_b64_tr_b16 %0, %1 offset:%c2" : "=&v"(dm) : "v"(va1[i & 3][0]), "i"((i >> 2) * 512) : "memory");
        asm volatile("s_waitcnt lgkmcnt(0)" ::: "memory"); }
#pragma unroll
    for (int step = 0; step < 4; ++step) {
        const int cur = step & 1, nxt = cur ^ 1;
        if (step < 3) {
#pragma unroll
            for (int e2 = 0; e2 < 4; ++e2) { TR_ISSUE(vlo[nxt][e2], va1[e2][0], 256 * (32 * ((step + 1) >> 1) + 16 * ((step + 1) & 1))); TR_ISSUE(vhi[nxt][e2], va1[e2][1], 256 * (32 * ((step + 1) >> 1) + 16 * ((step + 1) & 1)) + 2048); } }
#pragma unroll
        for (int et = 0; et < 4; ++et) MF32(o[et], VFRAG(cur, et), pa1[step >> 1][step & 1]);
        if (step < 3) tr_wait<4>(vlo[nxt], vhi[nxt]);
        SBAR0();
    }
}

constexpr int N_DIFF_ITEMS = 768, N_MEM_ITEMS = 256;
constexpr int XCH_OFF = 65536, CTL_OFF = 131072;

__device__ __forceinline__ int diff_item(ldsp lds, int qt, int bh, bool pre, unsigned* nctr, const bf16* U, bf16* O, const float* subw, float lam, float omlinit, float M0, int wave, int lane) {
    const int b = bh / 6, h = bh % 6;
    const int c = wave >> 2, wq = wave & 3, r = lane & 31, hh = lane >> 5;
    const size_t tokbase = (size_t)b * SEQ; const int t0 = 128 * qt + 32 * wq;
    bf16x8 qf[4];
    { const bf16* qp = U + (tokbase + t0 + r) * INW + h * 128 + c * 64 + 8 * hh;
#pragma unroll
      for (int ks = 0; ks < 4; ++ks) qf[ks] = *(const bf16x8*)(qp + 16 * ks); }
    f32x16 o[4];
#pragma unroll
    for (int et = 0; et < 4; ++et)
#pragma unroll
        for (int i = 0; i < 16; ++i) o[et][i] = 0.f;
    float lsum = 0.f;
    const float nslope2 = -exp2f(-8.0f * (float)(h + 1) / 6.0f) * LOG2E;
    const int jmax = 2 * qt + (wq >> 1);
    const unsigned lds0 = (unsigned)(size_t)lds; LaneAddr LA; lane_addr<4>(LA, 8 * c, 0, lane);
    const int prow = lane >> 4, chp = lane & 15;
    const bf16* kvsrc[4]; int pofs[4];
#pragma unroll
    for (int i = 0; i < 4; ++i) { const int pi = wave * 4 + i, row = 4 * pi + prow; const unsigned ch = (unsigned)chp ^ (((unsigned)prow << 2) | ((unsigned)pi & 3u));
        kvsrc[i] = U + (tokbase + row) * INW + 768 + h * 128 + ch * 8; pofs[i] = 1024 * pi; }
#define LOAD_PAIR(stage, s0) do { _Pragma("unroll") for (int i_ = 0; i_ < 4; ++i_) { const bf16* src_ = kvsrc[i_] + (size_t)(s0) * INW; \
        dma16(src_, lds + (stage) + pofs[i_]); dma16(src_ + 768, lds + (stage) + 32768 + pofs[i_]); } } while (0)
    if (!pre) LOAD_PAIR(0, 0);
    wait_all_barrier();
    for (int p = 0; p < qt; ++p) {
        const int stage = (p & 1) * 65536;
        LOAD_PAIR(((p + 1) & 1) * 65536, 128 * (p + 1)); if (PROBE == 6) LOAD_PAIR(((p + 1) & 1) * 65536, 128 * (p + 1));
        attn_pair<true>(o, lsum, qf, LA, lds0 + stage, lds0 + stage + 32768, lds0 + stage + 16384, lds0 + stage + 32768 + 16384, nslope2, -M0, (float)(t0 + r - 128 * p - 4 * hh), (float)(t0 + r - 128 * p - 64 - 4 * hh));
        wait_all_barrier();
    }
    {
        const int stage = (qt & 1) * 65536;
        unsigned nt = 0u; if (wave == 0 && lane == 0) nt = atomicAdd(nctr, 1u);
        if (wq >= 2) attn_pair<true, false>(o, lsum, qf, LA, lds0 + stage, lds0 + stage + 32768, lds0 + stage + 16384, lds0 + stage + 32768 + 16384, nslope2, -M0, (float)(t0 + r - 128 * qt - 4 * hh), (float)(t0 + r - 128 * qt - 64 - 4 * hh));
        else attn_tile<4, true>(o, lsum, qf, LA, lds0 + stage, lds0 + stage + 32768, nslope2, -M0, (float)(t0 + r - 128 * qt - 4 * hh));
        if (wave == 0 && lane == 0) ((ALDS unsigned*)(lds + CTL_OFF))[3] = nt;
        wait_all_barrier();
    }
#undef LOAD_PAIR
    const int nli = __builtin_amdgcn_readfirstlane((int)((ALDS unsigned*)(lds + CTL_OFF))[3]);
    if (nli < 96) {
        const int nbh = (bh & 7) + 8 * (nli % 3), nb = nbh / 6, nh = nbh % 6;
#pragma unroll
        for (int i = 0; i < 4; ++i) { const int pi = wave * 4 + i, row = 4 * pi + prow; const unsigned ch = (unsigned)chp ^ (((unsigned)prow << 2) | ((unsigned)pi & 3u));
            const bf16* src = U + ((size_t)nb * SEQ + row) * INW + 768 + nh * 128 + ch * 8;
            dma16(src, lds + 1024 * pi); dma16(src + 768, lds + 32768 + 1024 * pi); }
    }
    int lane_e = lane; asm volatile("" : "+v"(lane_e));
    const int r_e = lane_e & 31, hh_e = lane_e >> 5;
    const float l = lsum + shx(lsum, 32);
    ALDS float* xp = (ALDS float*)(lds + XCH_OFF + wq * 16384);
    if (c == 1) { const float inv = lam / l;
#pragma unroll
        for (int et = 0; et < 4; ++et)
#pragma unroll
            for (int i = 0; i < 16; ++i) xp[(et * 16 + i) * 64 + lane_e] = o[et][i] * inv; }
    asm volatile("s_waitcnt lgkmcnt(0)\n\ts_barrier" ::: "memory");
    if (c == 0) { const float inv = 1.0f / l; float ssq = 0.f;
#pragma unroll
        for (int et = 0; et < 4; ++et)
#pragma unroll
            for (int i = 0; i < 16; ++i) { const float d = o[et][i] * inv - xp[(et * 16 + i) * 64 + lane_e]; o[et][i] = d; ssq += d * d; }
        ssq += shx(ssq, 32);
        const float rs = omlinit / sqrtf(ssq * (1.0f / 128.0f) + EPS);
        bf16* op = O + (tokbase + t0 + r_e) * D + h * 128 + 4 * hh_e;
        const float* swp = subw; asm volatile("" : "+s"(swp));
#pragma unroll
        for (int et = 0; et < 4; ++et)
#pragma unroll
            for (int g4 = 0; g4 < 4; ++g4) { const int e0 = 32 * et + 8 * g4; const f32x4 w = *(const f32x4*)(swp + e0 + 4 * hh_e);
                v2u pk; pk.x = cvtpk(o[et][4 * g4] * rs * w[0], o[et][4 * g4 + 1] * rs * w[1]); pk.y = cvtpk(o[et][4 * g4 + 2] * rs * w[2], o[et][4 * g4 + 3] * rs * w[3]);
                *(v2u*)(op + e0) = pk; }
    }
    return nli;
}
__device__ __forceinline__ void mem_item(ldsp lds, int idx, const bf16* U, const bf16* MKVl, bf16* O, float M0, int wave, int lane) {
    const int bhm = idx >> 4, qb = idx & 15, b = bhm >> 2, hm = bhm & 3;
    const int r = lane & 31, hh = lane >> 5;
    const size_t tokbase = (size_t)b * SEQ; const int t0 = 256 * qb + 32 * wave;
    const int prow = lane >> 4, chp = lane & 15;
#pragma unroll
    for (int i = 0; i < 8; ++i) { const int pi = wave * 8 + i, row = 4 * pi + prow; const unsigned ch = (unsigned)chp ^ (((unsigned)prow << 2) | ((unsigned)pi & 3u));
        const bf16* src = MKVl + (size_t)(b * 256 + row) * 512 + hm * 64 + (ch < 8u ? ch * 8u : 256u + (ch - 8u) * 8u);
        dma16(src, lds + 1024 * pi); }
    bf16x8 qf[4];
    { const bf16* qp = U + (tokbase + t0 + r) * INW + 2304 + hm * 64 + 8 * hh;
#pragma unroll
      for (int ks = 0; ks < 4; ++ks) qf[ks] = *(const bf16x8*)(qp + 16 * ks); }
    f32x16 o[2];
#pragma unroll
    for (int et = 0; et < 2; ++et)
#pragma unroll
        for (int i = 0; i < 16; ++i) o[et][i] = 0.f;
    float lsum = 0.f;
    const unsigned lds0 = (unsigned)(size_t)lds; LaneAddr LA; lane_addr<2>(LA, 0, 8, lane);
    wait_all_barrier();
#pragma unroll 1
    for (int j = 0; j < 4; ++j) attn_tile<2, false>(o, lsum, qf, LA, lds0 + j * 16384, lds0 + j * 16384, 0.f, -M0, 0.f);
    const float inv = 1.0f / (lsum + shx(lsum, 32));
    bf16* op = O + (tokbase + t0 + r) * D + MAINW + hm * 64 + 4 * hh;
#pragma unroll
    for (int et = 0; et < 2; ++et)
#pragma unroll
        for (int g4 = 0; g4 < 4; ++g4) { const int e0 = 32 * et + 8 * g4;
            v2u pk; pk.x = cvtpk(o[et][4 * g4] * inv, o[et][4 * g4 + 1] * inv); pk.y = cvtpk(o[et][4 * g4 + 2] * inv, o[et][4 * g4 + 3] * inv);
            *(v2u*)(op + e0) = pk; }
}
}


namespace ret {
using namespace att;
constexpr int N_ITEMS = BATCH * 64 * 6;
constexpr int STAGE = 49152;
constexpr int RED_OFF = 2 * STAGE;

__device__ __forceinline__ bf16x8 tr_nat(unsigned img, int c, int ks, int lane) {
    const unsigned hh = lane >> 5, blk = (lane >> 4) & 1, qq = (lane & 15) >> 2, p = lane & 3;
    const unsigned row0 = 16u * ks + 8u * hh + qq, ch = 4u * c + 2u * blk + (p >> 1);
    const s16x4 lo = vtr((ldsp)(size_t)(img + off_b(row0, ch) + 8u * (p & 1u))), hi = vtr((ldsp)(size_t)(img + off_b(row0 + 4u, ch) + 8u * (p & 1u)));
    return (bf16x8){lo[0], lo[1], lo[2], lo[3], hi[0], hi[1], hi[2], hi[3]};
}
__device__ __forceinline__ bf16x8 tr_perm(unsigned img, int c, int sub, int st, int lane) {
    const unsigned hh = lane >> 5, blk = (lane >> 4) & 1, qq = (lane & 15) >> 2, p = lane & 3;
    const unsigned row0 = 32u * sub + 16u * st + 4u * hh + qq, ch = 4u * c + 2u * blk + (p >> 1);
    const s16x4 lo = vtr((ldsp)(size_t)(img + off_b(row0, ch) + 8u * (p & 1u))), hi = vtr((ldsp)(size_t)(img + off_b(row0 + 8u, ch) + 8u * (p & 1u)));
    return (bf16x8){lo[0], lo[1], lo[2], lo[3], hi[0], hi[1], hi[2], hi[3]};
}
__device__ __forceinline__ float bfs(short v) { return __builtin_bit_cast(float, (unsigned)(unsigned short)v << 16); }
__device__ __forceinline__ void decode(int item, int& b, int& n, int& h) { h = item % 6; const int bn = item / 6; n = bn & 63; b = bn >> 6; }

template <bool WITH_PREV>
__device__ __forceinline__ void stage_item(ldsp lds, int stage, int item, const bf16* U, const bf16* PREV, int wave, int lane) {
    int b, n, h; decode(item, b, n, h);
    const int prow = lane >> 4, chp = lane & 15;
#pragma unroll
    for (int i = 0; i < 2; ++i) { const int pi = wave * 2 + i, row = 4 * pi + prow; const unsigned ch = (unsigned)chp ^ (((unsigned)prow << 2) | ((unsigned)pi & 3u));
        const bf16* urow = U + ((size_t)b * SEQ + 64 * n + row) * INW;
        dma16(urow + (ch < 8u ? 384 + h * 64 + ch * 8 : h * 64 + (ch - 8u) * 8), lds + stage + 1024 * pi);
        dma16(urow + 768 + h * 128 + ch * 8, lds + stage + 16384 + 1024 * pi);
        if (WITH_PREV) dma16(PREV + ((size_t)item * 64 + row) * 128 + ch * 8, lds + stage + 32768 + 1024 * pi); }
}

__device__ __forceinline__ void r1_phase(ldsp lds, const bf16* U, bf16* KV, int G, int bx, int wave, int lane) {
    const unsigned lds0 = (unsigned)(size_t)lds;
    const int dt = wave & 1, et = wave >> 1, r = lane & 31, hh = lane >> 5;
    if (bx < N_ITEMS) stage_item<false>(lds, 0, bx, U, nullptr, wave, lane);
    wait_all_barrier();
    int k = 0;
    for (int item = bx; item < N_ITEMS; item += G, ++k) {
        const unsigned st = lds0 + (k & 1) * STAGE;
        if (item + G < N_ITEMS) stage_item<false>(lds, ((k + 1) & 1) * STAGE, item + G, U, nullptr, wave, lane);
        int b, n, h; decode(item, b, n, h);
        const float lg2 = log2f(1.0f - exp2f(-5.0f - (float)h));
        f32x16 acc;
#pragma unroll
        for (int i = 0; i < 16; ++i) acc[i] = 0.f;
#pragma unroll
        for (int ks = 0; ks < 4; ++ks) {
            const bf16x8 kf = tr_nat(st, dt, ks, lane), vf = tr_nat(st + 16384, et, ks, lane);
            float kd[8];
#pragma unroll
            for (int jj = 0; jj < 8; ++jj) kd[jj] = bfs(kf[jj]) * __builtin_amdgcn_exp2f(lg2 * (float)(63 - (16 * ks + 8 * hh + jj)));
            typedef unsigned u4 __attribute__((ext_vector_type(4)));
            u4 w; w.x = cvtpk(kd[0], kd[1]); w.y = cvtpk(kd[2], kd[3]); w.z = cvtpk(kd[4], kd[5]); w.w = cvtpk(kd[6], kd[7]);
            acc = __builtin_amdgcn_mfma_f32_32x32x16_bf16(vf, __builtin_bit_cast(bf16x8, w), acc, 0, 0, 0);
        }
        wait_all_barrier();
        bf16* kvp = KV + ((size_t)item * 64 + 32 * dt + r) * 128 + 32 * et + 4 * hh;
#pragma unroll
        for (int g4 = 0; g4 < 4; ++g4) { v2u pk; pk.x = cvtpk(acc[4 * g4], acc[4 * g4 + 1]); pk.y = cvtpk(acc[4 * g4 + 2], acc[4 * g4 + 3]); *(v2u*)(kvp + 8 * g4) = pk; }
    }
}
__device__ __forceinline__ void r2_phase(const bf16* __restrict__ KV, bf16* __restrict__ PREV, int gtid, int gthreads) {
    for (int idx = gtid; idx < BATCH * 6 * 64 * 64; idx += gthreads) {
        const int e2 = idx & 63, d = (idx >> 6) & 63, bh = idx >> 12, h = bh % 6, b = bh / 6;
        const float cd = exp2f(64.0f * log2f(1.0f - exp2f(-5.0f - (float)h)));
        float s0 = 0.f, s1 = 0.f;
        const size_t base = (((size_t)b * 64 * 6 + h) * 64 + d) * 128 + 2 * e2, nstride = (size_t)6 * 64 * 128;
#pragma unroll 32
        for (int n = 0; n < 64; ++n) {
            const unsigned kvw = *(const unsigned*)(KV + base + n * nstride);
            *(unsigned*)(PREV + base + n * nstride) = cvtpk(s0, s1);
            s0 = s0 * cd + bflo(kvw); s1 = s1 * cd + bfhi(kvw);
        }
    }
}
__device__ __forceinline__ void r3_phase(ldsp lds, const bf16* U, const bf16* PREV, bf16* O, const float* gnw, int G, int bx, int wave, int lane) {
    const unsigned lds0 = (unsigned)(size_t)lds;
    const int it = wave & 1, et = wave >> 1, r = lane & 31, hh = lane >> 5;
    if (bx < N_ITEMS) stage_item<true>(lds, 0, bx, U, PREV, wave, lane);
    wait_all_barrier();
    int k = 0;
    for (int item = bx; item < N_ITEMS; item += G, ++k) {
        const unsigned st = lds0 + (k & 1) * STAGE;
        if (item + G < N_ITEMS) stage_item<true>(lds, ((k + 1) & 1) * STAGE, item + G, U, PREV, wave, lane);
        int b, n, h; decode(item, b, n, h);
        const float lg2 = log2f(1.0f - exp2f(-5.0f - (float)h));
        bf16x8 qf[4];
#pragma unroll
        for (int ks = 0; ks < 4; ++ks) qf[ks] = *(const ALDS bf16x8*)(size_t)(st + off_b(32u * it + r, 8u + 2u * ks + hh));
        bf16x8 pa[2][2];
        const int irow = 32 * it + r;
#pragma unroll
        for (int sub = 0; sub < 2; ++sub) {
            f32x16 s;
#pragma unroll
            for (int i = 0; i < 16; ++i) s[i] = 0.f;
#pragma unroll
            for (int ks = 0; ks < 4; ++ks) { const bf16x8 kf = *(const ALDS bf16x8*)(size_t)(st + off_b(32u * sub + r, 2u * ks + hh)); s = __builtin_amdgcn_mfma_f32_32x32x16_bf16(kf, qf[ks], s, 0, 0, 0); }
#pragma unroll
            for (int i = 0; i < 16; ++i) { const int jrow = 32 * sub + (i & 3) + 8 * (i >> 2) + 4 * hh; s[i] *= __builtin_amdgcn_exp2f(lg2 * fabsf((float)(irow - jrow))); }
            pa[sub][0] = pack8s(s, 0); pa[sub][1] = pack8s(s, 8);
        }
        f32x16 oin, ox;
#pragma unroll
        for (int i = 0; i < 16; ++i) { oin[i] = 0.f; ox[i] = 0.f; }
#pragma unroll
        for (int sub = 0; sub < 2; ++sub)
#pragma unroll
            for (int s2 = 0; s2 < 2; ++s2) oin = __builtin_amdgcn_mfma_f32_32x32x16_bf16(tr_perm(st + 16384, et, sub, s2, lane), pa[sub][s2], oin, 0, 0, 0);
#pragma unroll
        for (int ks = 0; ks < 4; ++ks) ox = __builtin_amdgcn_mfma_f32_32x32x16_bf16(tr_nat(st + 32768, et, ks, lane), qf[ks], ox, 0, 0, 0);
        const float dec = __builtin_amdgcn_exp2f(lg2 * (float)(irow + 1));
        float ssq = 0.f;
#pragma unroll
        for (int i = 0; i < 16; ++i) { oin[i] = fmaf(dec, ox[i], oin[i]); ssq += oin[i] * oin[i]; }
        ssq += shx(ssq, 32);
        ALDS float* red = (ALDS float*)(lds + RED_OFF + (k & 1) * 1024);
        if (hh == 0) red[(et * 2 + it) * 32 + r] = ssq;
        wait_all_barrier();
        const float tot = (red[(0 * 2 + it) * 32 + r] + red[(1 * 2 + it) * 32 + r]) + (red[(2 * 2 + it) * 32 + r] + red[(3 * 2 + it) * 32 + r]);
        const float rs = 1.0f / sqrtf(tot * (1.0f / 128.0f) + EPS);
        const size_t tok = (size_t)b * SEQ + 64 * n + irow;
        const float* gb = gnw; asm volatile("" : "+s"(gb));
        const float* gp = gb + h * 128 + 32 * et + 4 * hh;
        const bf16* gatep = U + tok * INW + 1536 + h * 128 + 32 * et + 4 * hh;
        bf16* op = O + tok * D + h * 128 + 32 * et + 4 * hh;
        f32x4 wq4[4]; v2u gq4[4];
#pragma unroll
        for (int g4 = 0; g4 < 4; ++g4) { wq4[g4] = *(const f32x4*)(gp + 8 * g4); gq4[g4] = *(const v2u*)(gatep + 8 * g4); }
#pragma unroll
        for (int g4 = 0; g4 < 4; ++g4) { const f32x4 w = wq4[g4]; const v2u gt = gq4[g4];
            v2u pk; pk.x = cvtpk(oin[4 * g4] * rs * w[0] * bflo(gt.x), oin[4 * g4 + 1] * rs * w[1] * bfhi(gt.x));
            pk.y = cvtpk(oin[4 * g4 + 2] * rs * w[2] * bflo(gt.y), oin[4 * g4 + 3] * rs * w[3] * bfhi(gt.y));
            *(v2u*)(op + 8 * g4) = pk; }
    }
}
}

typedef const __attribute__((address_space(4))) Args* ArgsP;
__device__ __forceinline__ ArgsP args_ptr() { ArgsP p = (ArgsP)__builtin_amdgcn_kernarg_segment_ptr(); asm volatile("" : "+s"(p)); return p; }
constexpr int XBAR_WORD0 = 4096, XBAR_LDS = 131072 + 64;
#define GRID_BAR() do { XcdBarrier xb_; xb_.bar = (unsigned*)(args_ptr()->ws + WS_CTL) + XBAR_WORD0; xb_.x = xb_xcc_id(); \
        xb_.st = (volatile LAS unsigned*)((LAS unsigned char*)lds + XBAR_LDS); xb_.leader = (wave_s == 0) && (__builtin_amdgcn_mbcnt_hi(~0u, __builtin_amdgcn_mbcnt_lo(~0u, 0u)) == 0u); xcd_barrier(xb_); } while (0)
#define TIDS() int lane_ = (int)__builtin_amdgcn_mbcnt_hi(~0u, __builtin_amdgcn_mbcnt_lo(~0u, 0u)); asm volatile("" : "+v"(lane_)); const int lane = lane_ & 63, wave = wave_s & 7, tid = wave * 64 + lane; const int G = gridDim.x, bx = blockIdx.x; (void)lane; (void)wave; (void)tid; (void)G; (void)bx
#define GIDS() const int gw = bx * NWAVES + wave, ngw = G * NWAVES, gtid = bx * NTHR + tid, gthreads = G * NTHR; (void)gw; (void)ngw; (void)gtid; (void)gthreads

constexpr int I_IN = 16 * 40, I_OUT = 16 * 16, I_GU = 16 * 88, I_DN = 44 * 16, I_MKV = 16 * 8, I_L = I_IN + I_OUT + I_GU + I_DN;
__device__ __forceinline__ void convert_layer(ArgsP a, int L, int first, int stride, int lane) {
    unsigned char* ws = a->ws;
    bf16* WIN = (bf16*)(ws + WS_WIN); bf16* WOUT = (bf16*)(ws + WS_WOUT); bf16* WGU = (bf16*)(ws + WS_WGU); bf16* WDN = (bf16*)(ws + WS_WDN);
    for (int r = first; r < I_L; r += stride) {
        if (r < I_IN) transpose_item(a->in[3] + (size_t)L * D * INW, D, INW, WIN + (size_t)L * INW * D, a->in[2] + L * D, 1, 0, r, lane);
        else if (r < I_IN + I_OUT) transpose_item(a->in[4] + (size_t)L * D * D, D, D, WOUT + (size_t)L * D * D, nullptr, 0, 0, r - I_IN, lane);
        else if (r < I_IN + I_OUT + I_GU) transpose_item(a->in[18] + (size_t)L * D * GU, D, GU, WGU + (size_t)L * GU * D, a->in[17] + L * D, 2, 0, r - I_IN - I_OUT, lane);
        else transpose_item(a->in[19] + (size_t)L * FFN * D, FFN, D, WDN + (size_t)L * D * FFN, nullptr, 0, 0, r - I_IN - I_OUT - I_GU, lane);
    }
}
__device__ __forceinline__ void phase_prologue(unsigned char* lds, int wave_s) {
    ArgsP a = args_ptr(); TIDS(); GIDS(); unsigned char* ws = a->ws;
    bf16* WMKV = (bf16*)(ws + WS_WMKV); bf16* MEMN = (bf16*)(ws + WS_MEMN); bf16* XB = (bf16*)(ws + WS_XB); float* SS = (float*)(ws + WS_SS);
    for (int it = gw; it < I_L + DEPTH * I_MKV; it += ngw) {
        if (it < I_L) convert_layer(a, 0, it, 1 << 30, lane);
        else { const int r = it - I_L, L = r / I_MKV; transpose_item(a->in[6] + (size_t)L * D * 512, D, 512, WMKV, nullptr, 1, 512 * L, r % I_MKV, lane); }
    }
    const float* x_in = a->in[0];
    for (int m = gw; m < MEMR; m += ngw) row_to_bf16(a->in[1] + (size_t)m * D, MEMN + (size_t)m * D, a->in[5], true, lane);
    for (int row = gw; row < M; row += 2 * ngw) {
        const int row2 = row + ngw; const bool two = row2 < M;
        const f32x4* x0 = (const f32x4*)(x_in + (size_t)row * D) + lane; const f32x4* x1 = (const f32x4*)(x_in + (size_t)(two ? row2 : row) * D) + lane;
        f32x4 v0[4], v1[4]; float s0 = 0.f, s1 = 0.f;
#pragma unroll
        for (int j = 0; j < 4; ++j) { v0[j] = __builtin_nontemporal_load(x0 + 64 * j); v1[j] = __builtin_nontemporal_load(x1 + 64 * j); }
#pragma unroll
        for (int j = 0; j < 4; ++j) { s0 += (v0[j].x * v0[j].x + v0[j].y * v0[j].y) + (v0[j].z * v0[j].z + v0[j].w * v0[j].w); s1 += (v1[j].x * v1[j].x + v1[j].y * v1[j].y) + (v1[j].z * v1[j].z + v1[j].w * v1[j].w); }
        s0 = wave_sum(s0); s1 = wave_sum(s1);
        unsigned long long* o0 = (unsigned long long*)(XB + (size_t)row * D) + lane;
#pragma unroll
        for (int j = 0; j < 4; ++j) o0[64 * j] = (unsigned long long)pk2(v0[j].x, v0[j].y) | ((unsigned long long)pk2(v0[j].z, v0[j].w) << 32);
        if (lane < 16) SS[(size_t)row * 16 + lane] = lane == 0 ? s0 : 0.f;
        if (two) { unsigned long long* o1 = (unsigned long long*)(XB + (size_t)row2 * D) + lane;
#pragma unroll
            for (int j = 0; j < 4; ++j) o1[64 * j] = (unsigned long long)pk2(v1[j].x, v1[j].y) | ((unsigned long long)pk2(v1[j].z, v1[j].w) << 32);
            if (lane < 16) SS[(size_t)row2 * 16 + lane] = lane == 0 ? s1 : 0.f; }
    }
}
__device__ __forceinline__ void phase_A(unsigned char* lds, int wave_s, int L) {
    ArgsP a = args_ptr(); TIDS(); unsigned char* ws = a->ws; const int j = L >> 1;
    pg8::Gemm g{(bf16*)(ws + WS_XB), (bf16*)(ws + WS_WIN) + (size_t)L * INW * D, M, INW, D}; pg8::StaticOrder S; S.init(M, INW, G, bx);
    pg8::EpiU E{(bf16*)(ws + WS_U), (const float*)(ws + WS_SS), L & 1, a->in[10] + j * 64, a->in[11] + j * 64, a->in[7] + L * 64, 0.125f * 1.4426950408889634f};
    if (L + 1 < DEPTH && bx >= 128 && bx < 224) { convert_layer(args_ptr(), L + 1, (bx - 128) * NWAVES + wave, 96 * NWAVES, lane); asm volatile("s_waitcnt vmcnt(0)" ::: "memory"); }
    pg8::gemm_phase<pg8::EpiU, pg8::StaticOrder, true, true>((pg8::PG8_LAS_T*)lds, g, S, E, tid);
}
__device__ __forceinline__ void phase_MKV(unsigned char* lds, int wave_s) {
    ArgsP a = args_ptr(); TIDS(); unsigned char* ws = a->ws;
    pg8::Gemm g2{(bf16*)(ws + WS_MEMN), (bf16*)(ws + WS_WMKV), MEMR, 2048, D}; pg8::TailOrder T{4, 8, G - 32, bx};
    pg8::EpiMKV E2{(bf16*)(ws + WS_MKV), a->in[8]};
    pg8::gemm_phase<pg8::EpiMKV, pg8::TailOrder, true, true>((pg8::PG8_LAS_T*)lds, g2, T, E2, tid);
}
__device__ __forceinline__ void phase_attn(unsigned char* lds_, int wave_s, int L, int rep = 0) {
    ArgsP a = args_ptr(); TIDS(); unsigned char* ws = a->ws; const int j = L >> 1; const bool diff = (L & 1) != 0;
    att::ldsp lds = (att::ldsp)lds_;
    ALDS unsigned* ctl = (ALDS unsigned*)(lds + att::CTL_OFF);
    unsigned* ctr = (unsigned*)(ws + WS_CTL) + 64 * L + 8 * rep;
    const bf16* U = (const bf16*)(ws + WS_U); bf16* O = (bf16*)(ws + WS_O); const bf16* MKVl = (const bf16*)(ws + WS_MKV) + (size_t)L * MEMR * 512;
    float M0d = 0.f, lam = 0.f, omlinit = 0.f;
    unsigned tk0 = 0u;
    if (diff && tid == 0) tk0 = atomicAdd((unsigned*)(ws + WS_CTL) + 1024 + 512 * L + 4 * rep + 64 * (int)(xb_xcc_id() & 7u), 1u);
    if (diff) {
        const float mq = att::wave_max(fabsf(a->in[10][j * 64 + lane])), mk = att::wave_max(fabsf(a->in[11][j * 64 + lane]));
        M0d = 8.0f * mq * mk * att::LOG2E * 1.05f;
        const float linit = 0.8f - 0.6f * expf(-0.3f * (float)L);
        const float d1 = wave_sum(a->in[12][j * 64 + lane] * a->in[13][j * 64 + lane]), d2 = wave_sum(a->in[14][j * 64 + lane] * a->in[15][j * 64 + lane]);
        lam = expf(d1) - expf(d2) + linit; omlinit = 1.0f - linit;
    }
    const float* subw = a->in[16] + j * 128;
    if (diff) {
        const int myx = (int)(xb_xcc_id() & 7u);
        unsigned* dctr = (unsigned*)(ws + WS_CTL) + 1024 + 512 * L + 4 * rep;
        int q = myx; bool first = true;
        if (wave >= 4) __builtin_amdgcn_s_setprio(1);
        for (;;) {
            if (tid == 0) ctl[0] = first ? tk0 : atomicAdd(dctr + 64 * q, 1u);
            first = false;
            att::wait_all_barrier();
            int li = __builtin_amdgcn_readfirstlane((int)ctl[0]); bool pre = false;
            while (li < 96) { const int nli = att::diff_item(lds, 31 - li / 3, q + 8 * (li % 3), pre, dctr + 64 * q, U, O, subw, lam, omlinit, M0d, wave, lane); pre = nli < 96; li = nli; }
            if (wave == 0) { const unsigned c = lane < 8 ? __hip_atomic_load(dctr + 64 * ((myx + lane) & 7), __ATOMIC_RELAXED, __HIP_MEMORY_SCOPE_AGENT) : 96u;
                const unsigned long long mk = __ballot(c < 96u);
                if (lane == 0) ctl[2] = mk ? (unsigned)((myx + (__ffsll((long long)mk) - 1)) & 7) : 8u; }
            att::wait_all_barrier();
            const int pick = __builtin_amdgcn_readfirstlane((int)ctl[2]);
            if (pick >= 8) break;
            q = pick;
        }
        __builtin_amdgcn_s_setprio(0);
    }
    int lane_m = lane; asm volatile("" : "+v"(lane_m));
    const float M0m = 8.0f * att::wave_max(fabsf(a->in[7][L * 64 + lane_m])) * att::wave_max(fabsf(a->in[8][L * 64 + lane_m])) * att::LOG2E * 1.05f;
    if (!diff) {
        for (int idx = bx; idx < att::N_MEM_ITEMS; idx += G) { att::wait_all_barrier(); att::mem_item(lds, idx, U, MKVl, O, M0m, wave, lane_m); }
    } else for (;;) {
        if (tid == 0) ctl[1] = atomicAdd(ctr + 32, 1u);
        att::wait_all_barrier();
        const int idx = __builtin_amdgcn_readfirstlane((int)ctl[1]);
        if (idx >= att::N_MEM_ITEMS) break;
        att::mem_item(lds, idx, U, MKVl, O, M0m, wave, lane_m);
    }
}
__device__ __forceinline__ void phase_R1(unsigned char* lds, int wave_s, int L) {
    ArgsP a = args_ptr(); TIDS(); unsigned char* ws = a->ws;
    ret::r1_phase((att::ldsp)lds, (const bf16*)(ws + WS_U), (bf16*)(ws + WS_KV), G, bx, wave, lane);
}
__device__ __forceinline__ void phase_R2(unsigned char* lds, int wave_s, int L) {
    ArgsP a = args_ptr(); TIDS(); GIDS(); unsigned char* ws = a->ws;
    ret::r2_phase((const bf16*)(ws + WS_KV), (bf16*)(ws + WS_KV + 24 * MiB), gtid, gthreads);
}
__device__ __forceinline__ void phase_R3(unsigned char* lds, int wave_s, int L) {
    ArgsP a = args_ptr(); TIDS(); unsigned char* ws = a->ws; const int j = L >> 1;
    ret::r3_phase((att::ldsp)lds, (const bf16*)(ws + WS_U), (const bf16*)(ws + WS_KV + 24 * MiB), (bf16*)(ws + WS_O), a->in[9] + j * 768, G, bx, wave, lane);
}
__device__ __forceinline__ void phase_C(unsigned char* lds, int wave_s, int L) {
    ArgsP a = args_ptr(); TIDS(); unsigned char* ws = a->ws; float* out = a->out;
    pg8::Gemm g{(bf16*)(ws + WS_O), (bf16*)(ws + WS_WOUT) + (size_t)L * D * D, M, D, D}; pg8::StaticOrder S; S.init(M, D, G, bx);
    pg8::EpiRes E{out, (bf16*)(ws + WS_XB), (float*)(ws + WS_SS), 0};
    pg8::gemm_phase<pg8::EpiRes, pg8::StaticOrder, true, true>((pg8::PG8_LAS_T*)lds, g, S, E, tid);
}
__device__ __forceinline__ void phase_D(unsigned char* lds, int wave_s, int L) {
    ArgsP a = args_ptr(); TIDS(); unsigned char* ws = a->ws;
    pg8::Gemm g{(bf16*)(ws + WS_XB), (bf16*)(ws + WS_WGU) + (size_t)L * GU * D, M, GU, D}; pg8::StaticOrder S; S.init(M, GU, G, bx);
    pg8::EpiSwi E{(bf16*)(ws + WS_ACT), (const float*)(ws + WS_SS)};
    pg8::gemm_phase<pg8::EpiSwi, pg8::StaticOrder, true, true>((pg8::PG8_LAS_T*)lds, g, S, E, tid);
}
__device__ __forceinline__ void phase_E(unsigned char* lds, int wave_s, int L) {
    ArgsP a = args_ptr(); TIDS(); unsigned char* ws = a->ws; float* out = a->out;
    pg8::Gemm g{(bf16*)(ws + WS_ACT), (bf16*)(ws + WS_WDN) + (size_t)L * D * FFN, M, D, FFN}; pg8::StaticOrder S; S.init(M, D, G, bx);
    pg8::EpiRes E{out, (bf16*)(ws + WS_XB), (float*)(ws + WS_SS), L == DEPTH - 1 ? 1 : 0};
    pg8::gemm_phase<pg8::EpiRes, pg8::StaticOrder, true, true>((pg8::PG8_LAS_T*)lds, g, S, E, tid);
}

__global__ void __launch_bounds__(NTHR, 2) fwd_megakernel(Args a_unused) {
    extern __shared__ __attribute__((aligned(16))) unsigned char lds[];
    cg::grid_group grid = cg::this_grid();
    const int wave_s = __builtin_amdgcn_readfirstlane((int)threadIdx.x >> 6);
    if (threadIdx.x < 2) ((LAS unsigned*)((LAS unsigned char*)lds + XBAR_LDS))[threadIdx.x] = 0u;
    __syncthreads();
    if (blockIdx.x == 0) { unsigned* cw = (unsigned*)(args_ptr()->ws + WS_CTL); for (int i = threadIdx.x; i < 16384; i += NTHR) cw[i] = 0u; }
    phase_prologue(lds, wave_s);
    if (PROBE == 1) phase_prologue(lds, wave_s);
    grid.sync();
    (void)xcd_barrier_post((unsigned*)(args_ptr()->ws + WS_CTL) + XBAR_WORD0, (volatile LAS unsigned*)((LAS unsigned char*)lds + XBAR_LDS),
                           (wave_s == 0) && (__builtin_amdgcn_mbcnt_hi(~0u, __builtin_amdgcn_mbcnt_lo(~0u, 0u)) == 0u));
    phase_MKV(lds, wave_s);
#define LAYER(L) do { \
        phase_A(lds, wave_s, L); \
        if (PROBE == 4) phase_A(lds, wave_s, L); \
        GRID_BAR(); \
        if (!((L) & 1)) { phase_R1(lds, wave_s, L); phase_attn(lds, wave_s, L); GRID_BAR(); phase_R2(lds, wave_s, L); GRID_BAR(); phase_R3(lds, wave_s, L); \
            if (PROBE == 3) { GRID_BAR(); phase_R1(lds, wave_s, L); GRID_BAR(); phase_R2(lds, wave_s, L); GRID_BAR(); phase_R3(lds, wave_s, L); } } \
        else { phase_attn(lds, wave_s, L); if (PROBE == 2) { GRID_BAR(); phase_attn(lds, wave_s, L, 1); } } \
        GRID_BAR(); \
        phase_C(lds, wave_s, L); \
        GRID_BAR(); \
        if (PROBE == 5) { GRID_BAR(); GRID_BAR(); GRID_BAR(); GRID_BAR(); GRID_BAR(); GRID_BAR(); } \
        phase_D(lds, wave_s, L); \
        if (PROBE == 4) phase_D(lds, wave_s, L); \
        GRID_BAR(); \
        phase_E(lds, wave_s, L); \
        if ((L) + 1 < DEPTH) GRID_BAR(); } while (0)
    LAYER(0); LAYER(1); LAYER(2); LAYER(3);
#undef LAYER
}

extern "C" void kernel_launch(void* const* d_in, const int* in_sizes, int n_in, void* d_out, int out_size, void* d_ws, size_t ws_size, hipStream_t stream) {
    static int grid_blocks = 0;
    if (grid_blocks == 0) {
        if (n_in != 20 || out_size != M * D || ws_size < WS_END) { fprintf(stderr, "kernel_launch: unexpected shapes (n_in %d, out %d, ws %zu)\n", n_in, out_size, ws_size); grid_blocks = -1; return; }
        int dev = 0, cus = 0, per_cu = 0;
        hipGetDevice(&dev);
        hipDeviceGetAttribute(&cus, hipDeviceAttributeMultiprocessorCount, dev);
        hipFuncSetAttribute((const void*)fwd_megakernel, hipFuncAttributeMaxDynamicSharedMemorySize, LDS_BYTES);
        hipOccupancyMaxActiveBlocksPerMultiprocessor(&per_cu, (const void*)fwd_megakernel, NTHR, LDS_BYTES);
        if (per_cu < 1) { fprintf(stderr, "kernel_launch: occupancy query says %d blocks per CU\n", per_cu); grid_blocks = -1; return; }
        grid_blocks = cus;
        fprintf(stderr, "kernel_launch: cus %d per_cu %d grid %d ws %zu\n", cus, per_cu, grid_blocks, ws_size);
    }
    if (grid_blocks < 0) return;
    Args a{};
    for (int i = 0; i < 20; ++i) a.in[i] = (const float*)d_in[i];
    a.out = (float*)d_out; a.ws = (unsigned char*)d_ws;
    void* args[] = {&a};
    hipError_t e = hipLaunchCooperativeKernel((const void*)fwd_megakernel, dim3(grid_blocks), dim3(NTHR), args, LDS_BYTES, stream);
    if (e != hipSuccess) fprintf(stderr, "cooperative launch failed: %s (grid %d)\n", hipGetErrorString(e), grid_blocks);
}
```
